# Optimizing an MI355X kernel written in HIP

```python
import jax
import jax.numpy as jnp
from jax import lax
import numpy as np

D_MODEL = 1024
BATCH = 16
SEQ = 256
DEPTH = 4
DEC_BATCH = 2
DEC_SEQ = 4096
PAST_LEN = 512

GRID_W = 64
HEAD_DIM = 64
N_DIR = 2
A_HEADS = 4
A_WIDTH = A_HEADS * HEAD_DIM
A_DECAY_RANK = 64
A_ICLR_RANK = 64
A_GATE_RANK = 128
B_HEADS = 4
B_NOPE = 64
B_ROPE = 32
B_VDIM = 64
B_Q_RANK = 256
B_KV_RANK = 128
B_WIDTH = B_HEADS * B_VDIM
C_BLOCKS = 4
C_WIDTH = C_BLOCKS * HEAD_DIM
C_CONV = 4
C_POW = 8.0
D_HEADS = 4
D_WIDTH = D_HEADS * HEAD_DIM
D_MIX = A_WIDTH + B_WIDTH + C_WIDTH + D_WIDTH
IN_SIZES = (A_WIDTH, A_WIDTH, A_WIDTH, A_DECAY_RANK, A_DECAY_RANK, A_ICLR_RANK, A_ICLR_RANK, A_GATE_RANK,
            B_Q_RANK, B_KV_RANK, B_ROPE,
            C_WIDTH, C_WIDTH,
            D_WIDTH, D_WIDTH, D_WIDTH, D_WIDTH, D_WIDTH)
D_IN = 3 * A_WIDTH + 2 * A_DECAY_RANK + 2 * A_ICLR_RANK + A_GATE_RANK + B_Q_RANK + B_KV_RANK + B_ROPE + 2 * C_WIDTH + 5 * D_WIDTH
D_FF = 2816
N_MOD = 9
CHUNK = 64
Q_BLOCK = 128
ROPE_BASE = 10000.0
LN_EPS = 1e-5
RMS_EPS = 1e-6
RWKV_GN_EPS = 64e-5
DN_ALPHA = (2 * DEPTH) ** 0.25
DN_BETA = (8 * DEPTH) ** -0.25

kernel_name = 'hybrid_diffusion_prefix_step'


def _layer_norm(x, g, b):
    xf = x.astype(jnp.float32)
    mu = jnp.mean(xf, -1, keepdims=True)
    var = jnp.mean(jnp.square(xf - mu), -1, keepdims=True)
    return ((xf - mu) * lax.rsqrt(var + LN_EPS)).astype(x.dtype) * g + b


def _rms_norm(x, g):
    xf = x.astype(jnp.float32)
    return (xf * lax.rsqrt(jnp.mean(jnp.square(xf), -1, keepdims=True) + RMS_EPS)).astype(x.dtype) * g


def _swiglu(h, w_in, w_out):
    gate, up = jnp.split(h @ w_in, 2, axis=-1)
    return (jax.nn.silu(gate) * up) @ w_out


def _axial_rope_tables(n_tokens):
    rows = n_tokens // GRID_W
    row = jnp.repeat(jnp.arange(rows, dtype=jnp.float32), GRID_W)
    col = jnp.tile(jnp.arange(GRID_W, dtype=jnp.float32), rows)
    half = B_ROPE // 2
    inv = jnp.power(ROPE_BASE, -jnp.arange(0, half, 2, dtype=jnp.float32) / half)
    ang_r = row[:, None] * inv
    ang_c = col[:, None] * inv
    ang = jnp.concatenate([ang_r, ang_r, ang_c, ang_c], axis=-1)
    return jnp.cos(ang), jnp.sin(ang)


def _rot_half(x):
    x1, x2 = jnp.split(x, 2, axis=-1)
    return jnp.concatenate([-x2, x1], axis=-1)


def _apply_axial_rope(x, cos, sin):
    xr, xc = jnp.split(x, 2, axis=-1)
    rot = jnp.concatenate([_rot_half(xr), _rot_half(xc)], axis=-1)
    return (x * cos + rot * sin).astype(x.dtype)


def _attend(q, k, v, scale):
    bsz, t, h, dk = q.shape
    dv = v.shape[-1]
    nb = t // Q_BLOCK
    qb = jnp.moveaxis(q.reshape(bsz, nb, Q_BLOCK, h, dk), 1, 0)

    def one_block(qi):
        s = jnp.einsum('bqhd,bkhd->bhqk', qi, k).astype(jnp.float32) * scale
        p = jax.nn.softmax(s, axis=-1).astype(v.dtype)
        return jnp.einsum('bhqk,bkhd->bqhd', p, v)

    o = lax.map(one_block, qb)
    return jnp.moveaxis(o, 0, 1).reshape(bsz, t, h, dv)


def _rwkv_scan(s0, r, w, k, v, kk, a, reverse):
    def step(s, inp):
        r_t, w_t, k_t, v_t, kk_t, a_t = inp
        s_kk = jnp.einsum('bhvk,bhk->bhv', s, kk_t)
        s = (s * w_t[:, :, None, :] - s_kk[..., None] * (kk_t * a_t)[:, :, None, :]
             + v_t[..., None] * k_t[:, :, None, :]).astype(s0.dtype)
        return s, jnp.einsum('bhvk,bhk->bhv', s, r_t)

    xs = tuple(jnp.moveaxis(z, 1, 0) for z in (r, w, k, v, kk, a))
    s_fin, o = lax.scan(step, s0, xs, reverse=reverse)
    return jnp.moveaxis(o, 0, 1), s_fin


def _rwkv_mix(r, k, v, xw, xa, xg, p, s0):
    bsz, t, _ = r.shape
    heads = lambda z: z.reshape(bsz, t, A_HEADS, HEAD_DIM)
    kk = heads(k * p['rwkv_kk']).astype(jnp.float32)
    kk = (kk / jnp.maximum(jnp.sqrt(jnp.sum(jnp.square(kk), -1, keepdims=True)), 1e-12)).astype(k.dtype)
    outs, bonus, finals = [], [], []
    for d in range(N_DIR):
        w_log = -jax.nn.softplus(-(p['rwkv_w0'][d] + jnp.tanh(xw[d]) @ p['rwkv_w2'][d])) - 0.5
        a = jax.nn.sigmoid(p['rwkv_a0'][d] + xa[d] @ p['rwkv_a2'][d])
        k_d = k * (1 + (a - 1) * p['rwkv_ka'])
        o, s_fin = _rwkv_scan(s0[:, d], heads(r), heads(jnp.exp(-jnp.exp(w_log))), heads(k_d), heads(v),
                              kk, heads(a), d == 1)
        outs.append(o)
        finals.append(s_fin)
        bonus.append(jnp.sum(heads(r * k_d * p['rwkv_rk']), -1, keepdims=True) * heads(v))
    of = (outs[0] + outs[1]).astype(jnp.float32)
    mu = jnp.mean(of, -1, keepdims=True)
    var = jnp.mean(jnp.square(of - mu), -1, keepdims=True)
    gn = ((of - mu) * lax.rsqrt(var + RWKV_GN_EPS)).astype(r.dtype) * p['rwkv_gn_g'].reshape(A_HEADS, HEAD_DIM) \
        + p['rwkv_gn_b'].reshape(A_HEADS, HEAD_DIM)
    g = jax.nn.sigmoid(xg) @ p['rwkv_g2']
    y = (gn + bonus[0] + bonus[1]).reshape(bsz, t, A_WIDTH) * g
    return y, jnp.stack(finals, axis=1)


def _lin_combine(e1, e2):
    a1, b1 = e1
    a2, b2 = e2
    return a1 * a2, a2 * b1 + b2


def _rglru_mix(xc, xgate, p, h0):
    bsz, t, _ = xc.shape
    u = lax.conv_general_dilated(xc, p['rglru_conv_w'][:, None, :], window_strides=(1,),
                                 padding=((C_CONV // 2, C_CONV // 2 - 1),),
                                 dimension_numbers=('NWC', 'WIO', 'NWC'),
                                 feature_group_count=C_WIDTH) + p['rglru_conv_b']
    ub = u.reshape(bsz, t, C_BLOCKS, HEAD_DIM)
    bd = lambda w, b: jnp.einsum('btgi,gij->btgj', ub, w).reshape(bsz, t, C_WIDTH) + b
    hs, finals = [], []
    for d in range(N_DIR):
        r = jax.nn.sigmoid(bd(p['rglru_wa'][d], p['rglru_ba'][d]))
        i = jax.nn.sigmoid(bd(p['rglru_wx'][d], p['rglru_bx'][d]))
        log_a = -C_POW * r * jax.nn.softplus(-p['rglru_lam'][d])
        a = jnp.exp(log_a)
        b = jnp.sqrt(-jnp.expm1(2.0 * log_a)) * (i * u)
        a_cum, b_cum = lax.associative_scan(_lin_combine, (a, b), reverse=(d == 1), axis=1)
        h = a_cum * h0[:, d, None, :] + b_cum
        hs.append(h)
        finals.append(h[:, 0] if d == 1 else h[:, -1])
    return (hs[0] + hs[1]) * jax.nn.gelu(xgate), jnp.stack(finals, axis=1)


def _gla_chunkwise(s0, q, k, v, log_g, reverse):
    if reverse:
        q, k, v, log_g = [jnp.flip(z, axis=1) for z in (q, k, v, log_g)]
    bsz, t, h, _ = q.shape
    n = t // CHUNK
    blocks = lambda z: z.reshape(bsz, n, CHUNK, h, z.shape[-1]).transpose(1, 0, 3, 2, 4)
    causal = jnp.tril(jnp.ones((CHUNK, CHUNK), dtype=bool))[:, :, None]

    def step(s, inp):
        qc, kc, vc, gc = inp
        b = jnp.cumsum(gc.astype(jnp.float32), axis=2)
        dec = jnp.exp(jnp.where(causal, b[:, :, :, None, :] - b[:, :, None, :, :], -jnp.inf))
        att = jnp.einsum('bhtk,bhtsk,bhsk->bhts', qc, dec, kc)
        o = jnp.einsum('bhtk,bhkv->bhtv', qc * jnp.exp(b), s) + jnp.einsum('bhts,bhsv->bhtv', att, vc)
        b_last = b[:, :, -1:, :]
        s = (jnp.exp(b_last[:, :, 0, :, None]) * s
             + jnp.einsum('bhsk,bhsv->bhkv', kc * jnp.exp(b_last - b), vc)).astype(s0.dtype)
        return s, o.astype(vc.dtype)

    s_fin, o = lax.scan(step, s0, tuple(blocks(z) for z in (q, k, v, log_g)))
    o = o.transpose(1, 0, 3, 2, 4).reshape(bsz, t, h, v.shape[-1])
    return (jnp.flip(o, axis=1) if reverse else o), s_fin


def _hgrn_mix(xq, xf, xi, xg, p, s0):
    bsz, t, _ = xq.shape
    heads = lambda z: z.reshape(bsz, t, D_HEADS, HEAD_DIM)
    q = heads(jax.nn.silu(xq))
    v = heads(xi)
    lb = p['hgrn_lb']
    outs, finals = [], []
    for d in range(N_DIR):
        g = lb[d] + (1 - lb[d]) * jax.nn.sigmoid(xf[d])
        o, s_fin = _gla_chunkwise(s0[:, d], q, heads(1 - g), v, heads(jnp.log(g)), d == 1)
        outs.append(o)
        finals.append(s_fin)
    y = _rms_norm(outs[0] + outs[1], p['hgrn_gn_g'].reshape(D_HEADS, HEAD_DIM)) * heads(jax.nn.silu(xg))
    return y.reshape(bsz, t, D_WIDTH), jnp.stack(finals, axis=1)


def _mla_project(xcq, xckv, p):
    bsz, t, _ = xcq.shape
    q = (_rms_norm(xcq, p['mla_qn_g']) @ p['mla_w_uq']).reshape(bsz, t, B_HEADS, B_NOPE + B_ROPE)
    return q, _rms_norm(xckv, p['mla_kvn_g'])


def _mla_keys(ckv, kpe, p):
    bsz, s, _ = ckv.shape
    kv = (ckv @ p['mla_w_ukv']).reshape(bsz, s, B_HEADS, B_NOPE + B_VDIM)
    k = jnp.concatenate([kv[..., :B_NOPE], jnp.broadcast_to(kpe[:, :, None, :], (bsz, s, B_HEADS, B_ROPE))], axis=-1)
    return k, kv[..., B_NOPE:]


def _mixer(h, p, ctx):
    bsz, t, _ = h.shape
    points = [int(i) for i in np.cumsum(IN_SIZES)[:-1]]
    (a_r, a_k, a_v, a_wf, a_wb, a_af, a_ab, a_g, b_cq, b_ckv, b_kpe,
     c_x, c_gate, d_q, d_ff, d_fb, d_i, d_g) = jnp.split(h @ p['w_in'], points, axis=-1)
    if ctx is None:
        s_rwkv0 = jnp.zeros((bsz, N_DIR, A_HEADS, HEAD_DIM, HEAD_DIM), h.dtype)
        h_rglru0 = jnp.zeros((bsz, N_DIR, C_WIDTH), h.dtype)
        s_hgrn0 = jnp.zeros((bsz, N_DIR, D_HEADS, HEAD_DIM, HEAD_DIM), h.dtype)
    else:
        ctx_ckv, ctx_kpe, s_rwkv0, h_rglru0, s_hgrn0 = ctx
    ya, s_rwkv = _rwkv_mix(a_r, a_k, a_v, (a_wf, a_wb), (a_af, a_ab), a_g, p, s_rwkv0)
    q, ckv = _mla_project(b_cq, b_ckv, p)
    if ctx is None:
        k, v = _mla_keys(ckv, b_kpe, p)
    else:
        cos, sin = _axial_rope_tables(t)
        q = jnp.concatenate([q[..., :B_NOPE], _apply_axial_rope(q[..., B_NOPE:], cos[:, None], sin[:, None])], axis=-1)
        k_lat, v_lat = _mla_keys(ckv, _apply_axial_rope(b_kpe, cos, sin), p)
        k_ctx, v_ctx = _mla_keys(ctx_ckv, ctx_kpe, p)
        k = jnp.concatenate([k_lat, k_ctx], axis=1)
        v = jnp.concatenate([v_lat, v_ctx], axis=1)
    yb = _attend(q, k, v, (B_NOPE + B_ROPE) ** -0.5).reshape(bsz, t, B_WIDTH)
    yc, h_rglru = _rglru_mix(c_x, c_gate, p, h_rglru0)
    yd, s_hgrn = _hgrn_mix(d_q, (d_ff, d_fb), d_i, d_g, p, s_hgrn0)
    y = jnp.concatenate([ya, yb, yc, yd], axis=-1) @ p['w_out']
    return y, (ckv, b_kpe, s_rwkv, h_rglru, s_hgrn)


def _block(x, cond, p, ctx):
    mods = jnp.split(jax.nn.silu(cond) @ p['w_ada'] + p['b_ada'], N_MOD, axis=-1)
    sh0, sc0, g0, sh1, sc1, g1, sh2, sc2, g2 = [m[:, None, :] for m in mods]
    ffn = lambda hh, j: _swiglu(hh, p['w_ffn_in'][j], p['w_ffn_out'][j])
    x = _layer_norm(DN_ALPHA * x + 0.5 * g0 * ffn(x * (1 + sc0) + sh0, 0), p['ln_g'][0], p['ln_b'][0])
    mix, ctx_out = _mixer(x * (1 + sc1) + sh1, p, ctx)
    x = _layer_norm(DN_ALPHA * x + g1 * mix, p['ln_g'][1], p['ln_b'][1])
    x = _layer_norm(DN_ALPHA * x + 0.5 * g2 * ffn(x * (1 + sc2) + sh2, 1), p['ln_g'][2], p['ln_b'][2])
    return x, ctx_out


def _lower_bounds(lb_logits):
    sm = jax.nn.softmax(lb_logits.astype(jnp.float32), axis=0)
    return (jnp.cumsum(sm, axis=0) - sm[0]).astype(lb_logits.dtype)


def setup_inputs(seed: int = 0) -> dict:
    key = jax.random.key(seed)
    ks = iter(jax.random.split(key, 64))
    nrm = lambda shape, scale=1.0: scale * jax.random.normal(next(ks), shape, jnp.float32)
    unif = lambda shape, lo, hi: jax.random.uniform(next(ks), shape, jnp.float32, lo, hi)
    logit = lambda u: jnp.log(u) - jnp.log1p(-u)
    L = DEPTH
    return {
        'x_prompt': nrm((BATCH, SEQ, D_MODEL)),
        'x_sample': nrm((DEC_BATCH, DEC_SEQ, D_MODEL)),
        'cache_mla_ckv': nrm((DEC_BATCH, L, PAST_LEN, B_KV_RANK)),
        'cache_mla_kpe': nrm((DEC_BATCH, L, PAST_LEN, B_ROPE)),
        'state_rwkv': nrm((DEC_BATCH, L, N_DIR, A_HEADS, HEAD_DIM, HEAD_DIM), 0.3),
        'state_rglru': nrm((DEC_BATCH, L, N_DIR, C_WIDTH), 0.5),
        'state_hgrn': nrm((DEC_BATCH, L, N_DIR, D_HEADS, HEAD_DIM, HEAD_DIM), 0.3),
        'c': nrm((DEC_BATCH, D_MODEL)),
        'c_ctx': nrm((D_MODEL,)),
        'w_ada': nrm((L, D_MODEL, N_MOD * D_MODEL), 0.5 * D_MODEL ** -0.5),
        'b_ada': nrm((L, N_MOD * D_MODEL), 0.02),
        'ln_g': 1.0 + nrm((L, 3, D_MODEL), 0.02),
        'ln_b': nrm((L, 3, D_MODEL), 0.02),
        'w_ffn_in': nrm((L, 2, D_MODEL, 2 * D_FF), D_MODEL ** -0.5),
        'w_ffn_out': nrm((L, 2, D_FF, D_MODEL), DN_BETA * D_FF ** -0.5),
        'w_in': nrm((L, D_MODEL, D_IN), D_MODEL ** -0.5),
        'w_out': nrm((L, D_MIX, D_MODEL), DN_BETA * D_MIX ** -0.5),
        'rwkv_w0': unif((L, N_DIR, A_WIDTH), -6.5, -1.5),
        'rwkv_w2': nrm((L, N_DIR, A_DECAY_RANK, A_WIDTH), 0.1 * A_DECAY_RANK ** -0.5),
        'rwkv_a0': nrm((L, N_DIR, A_WIDTH), 0.1),
        'rwkv_a2': nrm((L, N_DIR, A_ICLR_RANK, A_WIDTH), 0.1 * A_ICLR_RANK ** -0.5),
        'rwkv_g2': nrm((L, A_GATE_RANK, A_WIDTH), A_GATE_RANK ** -0.5),
        'rwkv_kk': 0.85 + nrm((L, A_WIDTH), 0.02),
        'rwkv_ka': 1.0 + nrm((L, A_WIDTH), 0.02),
        'rwkv_rk': nrm((L, A_WIDTH), 0.1),
        'rwkv_gn_g': 1.0 + nrm((L, A_WIDTH), 0.02),
        'rwkv_gn_b': nrm((L, A_WIDTH), 0.02),
        'mla_qn_g': 1.0 + nrm((L, B_Q_RANK), 0.02),
        'mla_w_uq': nrm((L, B_Q_RANK, B_HEADS * (B_NOPE + B_ROPE)), B_Q_RANK ** -0.5),
        'mla_kvn_g': 1.0 + nrm((L, B_KV_RANK), 0.02),
        'mla_w_ukv': nrm((L, B_KV_RANK, B_HEADS * (B_NOPE + B_VDIM)), B_KV_RANK ** -0.5),
        'rglru_conv_w': nrm((L, C_CONV, C_WIDTH), C_CONV ** -0.5),
        'rglru_conv_b': nrm((L, C_WIDTH), 0.02),
        'rglru_wa': nrm((L, N_DIR, C_BLOCKS, HEAD_DIM, HEAD_DIM), HEAD_DIM ** -0.5),
        'rglru_ba': nrm((L, N_DIR, C_WIDTH), 0.02),
        'rglru_wx': nrm((L, N_DIR, C_BLOCKS, HEAD_DIM, HEAD_DIM), HEAD_DIM ** -0.5),
        'rglru_bx': nrm((L, N_DIR, C_WIDTH), 0.02),
        'rglru_lam': logit(unif((L, N_DIR, C_WIDTH), 0.9, 0.999)),
        'hgrn_lb': nrm((L, N_DIR, D_WIDTH), 0.1),
        'hgrn_gn_g': 1.0 + nrm((L, D_WIDTH), 0.02),
    }


def reference(x_prompt, x_sample, cache_mla_ckv, cache_mla_kpe, state_rwkv, state_rglru, state_hgrn, c, c_ctx,
              w_ada, b_ada, ln_g, ln_b, w_ffn_in, w_ffn_out, w_in, w_out,
              rwkv_w0, rwkv_w2, rwkv_a0, rwkv_a2, rwkv_g2, rwkv_kk, rwkv_ka, rwkv_rk, rwkv_gn_g, rwkv_gn_b,
              mla_qn_g, mla_w_uq, mla_kvn_g, mla_w_ukv,
              rglru_conv_w, rglru_conv_b, rglru_wa, rglru_ba, rglru_wx, rglru_bx, rglru_lam,
              hgrn_lb, hgrn_gn_g):
    lbs = _lower_bounds(hgrn_lb)

    def layer_params(l):
        return {'w_ada': w_ada[l], 'b_ada': b_ada[l], 'ln_g': ln_g[l], 'ln_b': ln_b[l],
                'w_ffn_in': w_ffn_in[l], 'w_ffn_out': w_ffn_out[l], 'w_in': w_in[l], 'w_out': w_out[l],
                'rwkv_w0': rwkv_w0[l], 'rwkv_w2': rwkv_w2[l], 'rwkv_a0': rwkv_a0[l], 'rwkv_a2': rwkv_a2[l],
                'rwkv_g2': rwkv_g2[l], 'rwkv_kk': rwkv_kk[l], 'rwkv_ka': rwkv_ka[l], 'rwkv_rk': rwkv_rk[l],
                'rwkv_gn_g': rwkv_gn_g[l], 'rwkv_gn_b': rwkv_gn_b[l],
                'mla_qn_g': mla_qn_g[l], 'mla_w_uq': mla_w_uq[l], 'mla_kvn_g': mla_kvn_g[l], 'mla_w_ukv': mla_w_ukv[l],
                'rglru_conv_w': rglru_conv_w[l], 'rglru_conv_b': rglru_conv_b[l],
                'rglru_wa': rglru_wa[l], 'rglru_ba': rglru_ba[l], 'rglru_wx': rglru_wx[l], 'rglru_bx': rglru_bx[l],
                'rglru_lam': rglru_lam[l], 'hgrn_lb': lbs[l], 'hgrn_gn_g': hgrn_gn_g[l]}

    x = x_prompt
    ctx_tensors = []
    for l in range(DEPTH):
        x, ctx_l = _block(x, c_ctx[None, :], layer_params(l), None)
        ctx_tensors.append(ctx_l)
    y_prompt = x
    new_mla_ckv = jnp.stack([e[0] for e in ctx_tensors], axis=1)
    new_mla_kpe = jnp.stack([e[1] for e in ctx_tensors], axis=1)
    new_rwkv = jnp.stack([e[2] for e in ctx_tensors], axis=1)
    new_rglru = jnp.stack([e[3] for e in ctx_tensors], axis=1)
    new_hgrn = jnp.stack([e[4] for e in ctx_tensors], axis=1)

    x = x_sample
    for l in range(DEPTH):
        cached = (cache_mla_ckv[:, l], cache_mla_kpe[:, l], state_rwkv[:, l], state_rglru[:, l], state_hgrn[:, l])
        x, _ = _block(x, c, layer_params(l), cached)
    y_sample = x
    return (y_prompt, y_sample, new_mla_ckv, new_mla_kpe, new_rwkv, new_rglru, new_hgrn)
```

```cpp
#include <hip/hip_runtime.h>
#include <hip/hip_bf16.h>
#include <hip/hip_cooperative_groups.h>
#include <cstdio>
#include <cstdint>
namespace cg = cooperative_groups;

#define DEV __device__ __forceinline__
typedef unsigned short u16;
#define AS1 __attribute__((address_space(1)))
typedef AS1 float* GF; typedef const AS1 float* GCF; typedef AS1 u16* GU; typedef const AS1 u16* GCU;
typedef const AS1 float4* GCF4; typedef AS1 float4* GF4; typedef const AS1 float2* GCF2; typedef AS1 float2* GF2;
typedef const AS1 uint4* GCU4; typedef AS1 uint4* GU4; typedef const AS1 uint2* GCU2; typedef AS1 uint2* GU2; typedef AS1 unsigned* GUI;
typedef float f4v_ __attribute__((ext_vector_type(4)));
__device__ __forceinline__ float4 ldg4(GCF q) { f4v_ v = *(const AS1 f4v_*)q; return make_float4(v.x, v.y, v.z, v.w); }
#define IN(i) ((GCF)p.in[i])
#define OUTP ((GF)p.out)
typedef __attribute__((ext_vector_type(8))) short bf16x8;
typedef __attribute__((ext_vector_type(4))) float f32x4;
typedef float f2_ __attribute__((ext_vector_type(2)));

constexpr int LDH = 1088, LDF = 2880;
constexpr int DM = 1024, MT_ROWS = 12288, MCTX = 4096, MKV = 13312, DFF = 2816, DIN = 3360, PLD = 3456;
constexpr float ALPHA = 1.6817928305074292f;
constexpr float QSCALE = 0.10206207261596575f * 1.4426950408889634f;
constexpr int C_AR = 0, C_AK = 256, C_AV = 512, C_AW = 768, C_AA = 896, C_AG = 1024, C_BQ = 1152, C_BKV = 1408, C_BPE = 1536,
              C_CX = 1568, C_CG = 1824, C_DQ = 2080, C_DF = 2336, C_DI = 2848, C_DG = 3104;
enum { I_XP = 0, I_XS, I_CCKV, I_CKPE, I_SRWKV, I_SRG, I_SHG, I_C, I_CCTX, I_WADA, I_BADA, I_LNG, I_LNB, I_WFI, I_WFO, I_WIN, I_WOUT,
       I_RW0, I_RW2, I_RA0, I_RA2, I_RG2, I_RKK, I_RKA, I_RRK, I_RGNG, I_RGNB, I_QNG, I_WUQ, I_KVNG, I_WUKV,
       I_CVW, I_CVB, I_GWA, I_GBA, I_GWX, I_GBX, I_GLAM, I_HLB, I_HGN };
constexpr size_t O_Y = 0, O_CKV = 12582912, O_KPE = 14680064, O_RWKV = 15204352, O_RGLRU = 17301504, O_HGRN = 17334272;

constexpr size_t al256(size_t x) { return (x + 255) & ~(size_t)255; }
constexpr size_t W_BAR = 0;
constexpr size_t W_CTR = 16384;
constexpr size_t W_WFI = 32768;
constexpr size_t W_WFO = W_WFI + (size_t)4 * 2 * 5632 * LDH * 2;
constexpr size_t W_WIN = W_WFO + (size_t)4 * 2 * 1024 * LDF * 2;
constexpr size_t W_WOUT = W_WIN + (size_t)4 * 3456 * LDH * 2;
constexpr size_t W_WUQ = W_WOUT + (size_t)4 * 1024 * LDH * 2;
constexpr size_t W_WUKV = W_WUQ + (size_t)4 * 384 * 256 * 2;
constexpr size_t W_MODS = W_WUKV + (size_t)4 * 512 * 128 * 2;
constexpr size_t W_LBS = W_MODS + (size_t)4 * 3 * 9216 * 4;
constexpr size_t W_X = W_LBS + 8192;
constexpr size_t W_H = W_X + (size_t)MT_ROWS * 1024 * 4;
constexpr size_t W_BIG = W_H + (size_t)MT_ROWS * LDH * 2;
constexpr size_t W_MIX = W_BIG + (size_t)MT_ROWS * PLD * 4;
constexpr size_t SZ_T = (size_t)MT_ROWS * 256 * 4;
constexpr size_t W_RWW = W_MIX + (size_t)MT_ROWS * LDH * 2;
constexpr size_t W_RWA = W_RWW + 2 * SZ_T;
constexpr size_t W_RWKK = W_RWA + 2 * SZ_T;
constexpr size_t W_RWG = W_RWKK + SZ_T;
constexpr size_t W_RWO = W_RWG + SZ_T;
constexpr size_t W_RGA = W_RWO + 2 * SZ_T;
constexpr size_t W_RGB = W_RGA + 2 * SZ_T;
constexpr size_t W_RGTA = W_RGB + 2 * SZ_T;
constexpr size_t W_RGTB = W_RGTA + (size_t)2 * 384 * 256 * 4;
constexpr size_t W_HGO = W_RGTB + (size_t)2 * 384 * 256 * 4;
constexpr size_t W_HGS = W_HGO + 2 * SZ_T;
constexpr size_t W_HGD = W_HGS + (size_t)1536 * 4096 * 4;
constexpr size_t W_CQN = W_HGD + (size_t)1536 * 64 * 4;
constexpr size_t W_CKVN = W_CQN + (size_t)MT_ROWS * 256 * 2;
constexpr size_t W_QB = W_CKVN + (size_t)MKV * 128 * 2;
constexpr size_t W_KB = W_QB + (size_t)MT_ROWS * 384 * 2;
constexpr size_t W_VT = W_KB + (size_t)MKV * 384 * 2;
constexpr size_t W_HGS2 = W_HGS;
constexpr size_t W_RWU = W_VT + (size_t)4 * 64 * MKV * 2;
constexpr size_t W_RWE = W_RWU + (size_t)2 * 8192 * 256 * 4;
constexpr size_t W_ROPE = W_RWE + (size_t)16 * 4 * 128 * 64 * 4;
constexpr size_t W_LW = W_ROPE + (size_t)4096 * 32 * 8;
constexpr size_t W_LA = W_LW + (size_t)4 * 512 * 128 * 2;
constexpr size_t W_LG = W_LA + (size_t)4 * 512 * 128 * 2;
constexpr size_t W_END = W_LG + (size_t)4 * 256 * 128 * 2;
constexpr size_t W_XD = W_BIG + (size_t)80 * 1024 * 1024;
constexpr size_t W_LIN = W_MIX;

struct P {
  const float* in[40];
  float* out;
  char* ws;
  int never;
  int pad;
};

DEV int tid_() { int t = __builtin_amdgcn_workitem_id_x(); asm volatile("" : "+v"(t)); return t; }
DEV unsigned pack2(float a, float b) { unsigned r; asm("v_cvt_pk_bf16_f32 %0, %1, %2" : "=v"(r) : "v"(a), "v"(b)); return r; }
DEV u16 f2bf(float f) { return (u16)(pack2(f, f) & 0xffffu); }
DEV float bf2f(u16 b) { return __uint_as_float(((unsigned)b) << 16); }
DEV float sigmoidf_(float x) { return 1.f / (1.f + __expf(-x)); }
DEV float siluf_(float x) { return x / (1.f + __expf(-x)); }
DEV float softplusf_(float x) { return fmaxf(x, 0.f) + __logf(1.f + __expf(-fabsf(x))); }
DEV float tanhf_(float x) { float e = __expf(2.f * x); return 1.f - 2.f / (e + 1.f); }
template <int CTRL> DEV float dppf(float x) {
  return __builtin_bit_cast(float, __builtin_amdgcn_update_dpp(0, __builtin_bit_cast(int, x), CTRL, 0xf, 0xf, false));
}
DEV float row16_sum(float x) {
  x += dppf<0x121>(x); x += dppf<0x122>(x); x += dppf<0x124>(x); x += dppf<0x128>(x);
  return x;
}
DEV float xrow_max(float x) {
  auto s = __builtin_amdgcn_permlane16_swap(__float_as_uint(x), __float_as_uint(x), false, false);
  x = fmaxf(__uint_as_float(s[0]), __uint_as_float(s[1]));
  auto t = __builtin_amdgcn_permlane32_swap(__float_as_uint(x), __float_as_uint(x), false, false);
  return fmaxf(__uint_as_float(t[0]), __uint_as_float(t[1]));
}
DEV float xrow_sum(float x) {
  auto s = __builtin_amdgcn_permlane16_swap(__float_as_uint(x), __float_as_uint(x), false, false);
  x = __uint_as_float(s[0]) + __uint_as_float(s[1]);
  auto t = __builtin_amdgcn_permlane32_swap(__float_as_uint(x), __float_as_uint(x), false, false);
  return __uint_as_float(t[0]) + __uint_as_float(t[1]);
}
DEV float wave_sum(float v) { return xrow_sum(row16_sum(v)); }
DEV int cond_idx(int m) { return m < MCTX ? 0 : 1 + ((m - MCTX) >> 12); }
DEV int seq_row0(int s) { return s < 16 ? s * 256 : MCTX + (s - 16) * 4096; }
DEV int seq_len(int s) { return s < 16 ? 256 : 4096; }

#define XB_TMO      128
#define XB_XCNT(j)  (256  + 64 * (j))
#define XB_XSUB(j)  (1280 + 64 * (j))
#define XB_XGEN(j)  (2304 + 64 * (j))
#define XB_TOP      3328
#define XB_TOPGEN   3392
#define XB_SPIN_CAP (1u << 22)
DEV unsigned xb_ld(unsigned* p) { return __hip_atomic_load(p, __ATOMIC_RELAXED, __HIP_MEMORY_SCOPE_AGENT); }
DEV unsigned xb_add(unsigned* p, unsigned v) { return __hip_atomic_fetch_add(p, v, __ATOMIC_RELAXED, __HIP_MEMORY_SCOPE_AGENT); }
DEV unsigned xb_xcc_id() { return (unsigned)__builtin_amdgcn_s_getreg((3 << 11) | 20) & 0xFu; }
#define XB_SPIN(cond, bar) do { unsigned _sp = 0; while (cond) { __builtin_amdgcn_s_sleep(1); \
    if ((++_sp & 255u) == 0u) { if (xb_ld(&(bar)[XB_TMO])) break; if (_sp > XB_SPIN_CAP) { atomicAdd(&(bar)[XB_TMO], 1u); break; } } } } while (0)

struct XcdBarrier { unsigned* bar; unsigned x; volatile unsigned* st; };

DEV void xcd_barrier_complete(unsigned* bar, unsigned x, unsigned& nloc, unsigned& nx) {
  const unsigned G = gridDim.x;
  unsigned sum, cnt, mine, sp = 0u;
  for (;;) {
    sum = 0u; cnt = 0u; mine = 0u;
#pragma unroll
    for (unsigned j = 0; j < 16; ++j) { const unsigned c = xb_ld(&bar[XB_XCNT(j)]); sum += c; cnt += (c > 0u) ? 1u : 0u; mine = (j == x) ? c : mine; }
    if (sum == G) break;
    __builtin_amdgcn_s_sleep(1);
    if ((++sp & 255u) == 0u) { if (xb_ld(&bar[XB_TMO])) break; if (sp > XB_SPIN_CAP) { atomicAdd(&bar[XB_TMO], 1u); break; } }
  }
  nloc = mine > 0u ? mine : 1u; nx = cnt > 0u ? cnt : 1u;
}
DEV void xcd_barrier(const XcdBarrier& b) {
  asm volatile("s_waitcnt vmcnt(0)" ::: "memory");
  __syncthreads();
  if (tid_() == 0) {
    unsigned* bar = b.bar;
    __builtin_amdgcn_s_waitcnt(0);
    unsigned nloc = b.st[0], nx = b.st[1];
    if (nloc == 0u) { xcd_barrier_complete(bar, b.x, nloc, nx); b.st[0] = nloc; b.st[1] = nx; }
    const unsigned old = xb_add(&bar[XB_XSUB(b.x)], 1u);
    const unsigned gen = old / nloc;
    if (old + 1u == (gen + 1u) * nloc) {
      __builtin_amdgcn_fence(__ATOMIC_RELEASE, "agent");
      asm volatile("s_waitcnt vmcnt(0)" ::: "memory");
      const unsigned og = xb_add(&bar[XB_TOP], 1u);
      const unsigned tg = og / nx;
      if (og + 1u == (tg + 1u) * nx) xb_add(&bar[XB_TOPGEN], 1u);
      else XB_SPIN(xb_ld(&bar[XB_TOPGEN]) == tg, bar);
      __builtin_amdgcn_fence(__ATOMIC_ACQUIRE, "agent");
      xb_add(&bar[XB_XGEN(b.x)], 1u);
      asm volatile("s_waitcnt vmcnt(0)" ::: "memory");
    } else {
      XB_SPIN(xb_ld(&bar[XB_XGEN(b.x)]) == gen, bar);
      __builtin_amdgcn_fence(__ATOMIC_ACQUIRE, "agent");
      asm volatile("s_waitcnt vmcnt(0)" ::: "memory");
    }
  }
  __syncthreads();
}
DEV void item_publish(unsigned* ctr) {
  asm volatile("s_waitcnt vmcnt(0)" ::: "memory");
  __syncthreads();
  if (tid_() == 0) {
    __builtin_amdgcn_fence(__ATOMIC_RELEASE, "agent");
    asm volatile("s_waitcnt vmcnt(0)" ::: "memory");
    xb_add(ctr, 1u);
  }
}
DEV void item_wait(unsigned* ctr, unsigned need) {
  if (tid_() == 0) {
    unsigned sp = 0;
    while (xb_ld(ctr) < need) { __builtin_amdgcn_s_sleep(4); if (++sp > (1u << 23)) break; }
    __builtin_amdgcn_fence(__ATOMIC_ACQUIRE, "agent");
    asm volatile("s_waitcnt vmcnt(0)" ::: "memory");
  }
  __syncthreads();
}
DEV int next_item(unsigned* ctr, volatile int* s_item) {
  __syncthreads();
  if (tid_() == 0) *s_item = (int)xb_add(ctr, 1u);
  __syncthreads();
  return *s_item;
}

template <int MAP>
DEV void cvt_tile(GCF src, int N, int k0, int n0, GU dst, int K, char* smem) {
  float* tile = (float*)smem;
  const int tid = tid_();
  float4 v[16];
#pragma unroll
  for (int i = 0; i < 16; ++i) {
    int r = (tid >> 5) + 8 * i, c = (tid & 31) * 4;
    v[i] = make_float4(0.f, 0.f, 0.f, 0.f);
    if (n0 + c < N) v[i] = *(const float4*)(src + (size_t)(k0 + r) * N + n0 + c);
  }
  __syncthreads();
#pragma unroll
  for (int i = 0; i < 16; ++i) {
    int r = (tid >> 5) + 8 * i, c = (tid & 31) * 4;
    tile[r * 129 + c] = v[i].x; tile[r * 129 + c + 1] = v[i].y; tile[r * 129 + c + 2] = v[i].z; tile[r * 129 + c + 3] = v[i].w;
  }
  __syncthreads();
#pragma unroll
  for (int i = 0; i < 8; ++i) {
    int idx = tid + 256 * i, n = idx >> 4, ch = idx & 15;
    unsigned w[4];
#pragma unroll
    for (int j = 0; j < 4; ++j) w[j] = pack2(tile[(ch * 8 + 2 * j) * 129 + n], tile[(ch * 8 + 2 * j + 1) * 129 + n]);
    int nn = n0 + n, drow = nn;
    if (MAP == 1) { int isup = nn >= DFF; int c = nn - isup * DFF; drow = (c >> 6) * 128 + ((c >> 5) & 1) * 64 + isup * 32 + (c & 31); }
    *(uint4*)(dst + (size_t)drow * K + k0 + ch * 8) = make_uint4(w[0], w[1], w[2], w[3]);
  }
}

DEV void mods_tile(const P& p, int item, char* smem) {
  float* sc = (float*)smem;
  float* red = sc + 3 * 1024;
  const int tid = tid_(), l = item / 72, ct = item % 72;
  __syncthreads();
  for (int i = tid; i < 3 * 1024; i += 256) {
    int r = i >> 10, k = i & 1023;
    float c = (r == 0) ? IN(I_CCTX)[k] : IN(I_C)[(r - 1) * 1024 + k];
    sc[i] = siluf_(c);
  }
  __syncthreads();
  const int kq = tid >> 5, c4 = (tid & 31) * 4;
  float acc[3][4];
#pragma unroll
  for (int r = 0; r < 3; ++r)
#pragma unroll
    for (int j = 0; j < 4; ++j) acc[r][j] = 0.f;
  auto w = IN(I_WADA) + ((size_t)l * 1024 + kq * 128) * 9216 + ct * 128 + c4;
#pragma unroll 8
  for (int k = 0; k < 128; ++k) {
    float4 v = *(const float4*)(w + (size_t)k * 9216);
    float s0 = sc[kq * 128 + k], s1 = sc[1024 + kq * 128 + k], s2 = sc[2048 + kq * 128 + k];
    acc[0][0] += s0 * v.x; acc[0][1] += s0 * v.y; acc[0][2] += s0 * v.z; acc[0][3] += s0 * v.w;
    acc[1][0] += s1 * v.x; acc[1][1] += s1 * v.y; acc[1][2] += s1 * v.z; acc[1][3] += s1 * v.w;
    acc[2][0] += s2 * v.x; acc[2][1] += s2 * v.y; acc[2][2] += s2 * v.z; acc[2][3] += s2 * v.w;
  }
#pragma unroll
  for (int r = 0; r < 3; ++r)
#pragma unroll
    for (int j = 0; j < 4; ++j) red[(kq * 3 + r) * 128 + c4 + j] = acc[r][j];
  __syncthreads();
  GF mods = (GF)(p.ws + W_MODS);
  for (int i = tid; i < 3 * 128; i += 256) {
    int r = i >> 7, c = i & 127;
    float s = 0.f;
#pragma unroll
    for (int q = 0; q < 8; ++q) s += red[(q * 3 + r) * 128 + c];
    int col = ct * 128 + c;
    mods[((size_t)l * 3 + r) * 9216 + col] = s + IN(I_BADA)[(size_t)l * 9216 + col];
  }
}

DEV void phase_setup0(const P& p, char* smem) {
  const int n0 = 8 * 352, n1 = 8 * 176, n2 = 4 * 216, n3 = 4 * 64, n4 = 4 * 6, n5 = 4 * 4, n6 = 288, n7 = 1;
  const int n8 = 512, n9 = 2560;
  const int total = n0 + n1 + n2 + n3 + n4 + n5 + n6 + n7 + n8 + n9;
  for (int it = blockIdx.x; it < total; it += gridDim.x) {
    int i = it;
    if (i >= total - n9) {
      int idx = (i - (total - n9)) * 256 + tid_();
      if (idx < 2 * 262144) {
        const int which = idx >> 18, e = idx & 262143, l = e >> 16, n = (e >> 7) & 511, k = e & 127;
        const int d = n >> 8, jc = n & 255;
        float v = 0.f;
        if ((k >> 6) == d) v = IN(which ? I_RA2 : I_RW2)[(((size_t)l * 2 + d) * 64 + (k & 63)) * 256 + jc];
        ((GU)(p.ws + (which ? W_LA : W_LW)))[e] = f2bf(v);
      } else {
        const int e = idx - 2 * 262144, l = e >> 15, n = (e >> 7) & 255, k = e & 127;
        ((GU)(p.ws + W_LG))[e] = f2bf(IN(I_RG2)[((size_t)l * 128 + k) * 256 + n]);
      }
      continue;
    }
    i = it;
    if (i >= total - n9 - n8) i += 0;
    if (i >= total - n9 - n8) {
      int idx = (i - (total - n9 - n8)) * 256 + tid_();
      int t = idx >> 5, ri = idx & 31;
      float pos = (float)((ri < 16) ? (t >> 6) : (t & 63));
      float inv = expf(-(float)(ri & 7) * (9.210340371976184f / 8.f));
      float sn, cs; sincosf(pos * inv, &sn, &cs);
      ((GF)(p.ws + W_ROPE))[idx * 2] = cs; ((GF)(p.ws + W_ROPE))[idx * 2 + 1] = sn;
      continue;
    }
    if (i < n6) { mods_tile(p, i, smem); continue; }
    i -= n6;
    if (i < n0) { int mat = i / 352, t = i % 352; int kt = t / 44, nt = t % 44;
      cvt_tile<1>(IN(I_WFI) + (size_t)mat * 1024 * 5632, 5632, kt * 128, nt * 128, (GU)(p.ws + W_WFI) + (size_t)mat * 5632 * LDH, LDH, smem); continue; }
    i -= n0;
    if (i < n1) { int mat = i / 176, t = i % 176; int kt = t / 8, nt = t % 8;
      cvt_tile<0>(IN(I_WFO) + (size_t)mat * 2816 * 1024, 1024, kt * 128, nt * 128, (GU)(p.ws + W_WFO) + (size_t)mat * 1024 * LDF, LDF, smem); continue; }
    i -= n1;
    if (i < n2) { int mat = i / 216, t = i % 216; int kt = t / 27, nt = t % 27;
      cvt_tile<0>(IN(I_WIN) + (size_t)mat * 1024 * DIN, DIN, kt * 128, nt * 128, (GU)(p.ws + W_WIN) + (size_t)mat * PLD * LDH, LDH, smem); continue; }
    i -= n2;
    if (i < n3) { int mat = i / 64, t = i % 64; int kt = t / 8, nt = t % 8;
      cvt_tile<0>(IN(I_WOUT) + (size_t)mat * 1024 * 1024, 1024, kt * 128, nt * 128, (GU)(p.ws + W_WOUT) + (size_t)mat * 1024 * LDH, LDH, smem); continue; }
    i -= n3;
    if (i < n4) { int mat = i / 6, t = i % 6; int kt = t / 3, nt = t % 3;
      cvt_tile<0>(IN(I_WUQ) + (size_t)mat * 256 * 384, 384, kt * 128, nt * 128, (GU)(p.ws + W_WUQ) + (size_t)mat * 384 * 256, 256, smem); continue; }
    i -= n4;
    if (i < n5) { int mat = i / 4, t = i % 4; int kt = t / 4, nt = t % 4;
      cvt_tile<0>(IN(I_WUKV) + (size_t)mat * 128 * 512, 512, kt * 128, nt * 128, (GU)(p.ws + W_WUKV) + (size_t)mat * 512 * 128, 128, smem); continue; }
    GF lbs = (GF)(p.ws + W_LBS);
    for (int e = tid_(); e < 512; e += 256) {
      float v[4], mx = -1e30f;
#pragma unroll
      for (int l = 0; l < 4; ++l) { v[l] = IN(I_HLB)[l * 512 + e]; mx = fmaxf(mx, v[l]); }
      float s = 0.f;
#pragma unroll
      for (int l = 0; l < 4; ++l) { v[l] = expf(v[l] - mx); s += v[l]; }
      float inv = 1.f / s, cum = 0.f;
#pragma unroll
      for (int l = 0; l < 4; ++l) { cum += v[l] * inv; lbs[l * 512 + e] = cum - v[0] * inv; }
    }
  }
}

DEV void phase_setup1(const P& p) {
  GCF mods = (GCF)(p.ws + W_MODS);
  GF x = (GF)(p.ws + W_X);
  GU h = (GU)(p.ws + W_H);
  const int lane = tid_() & 63, wid = tid_() >> 6;
  for (int m = blockIdx.x * 4 + wid; m < MT_ROWS; m += gridDim.x * 4) {
    auto src = m < MCTX ? IN(I_XP) + (size_t)m * 1024 : IN(I_XS) + (size_t)(m - MCTX) * 1024;
    auto md = mods + (size_t)cond_idx(m) * 9216;
#pragma unroll
    for (int i = 0; i < 4; ++i) {
      int c = lane * 4 + 256 * i;
      float4 v = *(const float4*)(src + c);
      float4 sh = *(const float4*)(md + c), sc = *(const float4*)(md + 1024 + c);
      *(float4*)(x + (size_t)m * 1024 + c) = v;
      uint2 o; o.x = pack2(v.x * (1.f + sc.x) + sh.x, v.y * (1.f + sc.y) + sh.y); o.y = pack2(v.z * (1.f + sc.z) + sh.z, v.w * (1.f + sc.w) + sh.w);
      *(uint2*)(h + (size_t)m * LDH + c) = o;
    }
  }
}

DEV void phase_ln(const P& p, int l, int j, int lm, int mi, bool last) {
  GCF mods = (GCF)(p.ws + W_MODS);
  GF x = (GF)(p.ws + W_X);
  GU h = (GU)(p.ws + W_H);
  auto g = IN(I_LNG) + ((size_t)l * 3 + j) * 1024;
  auto b = IN(I_LNB) + ((size_t)l * 3 + j) * 1024;
  const int lane = tid_() & 63, wid = tid_() >> 6;
  float4 gg4[4], bb4[4];
#pragma unroll
  for (int i = 0; i < 4; ++i) { gg4[i] = *(const float4*)(g + lane * 4 + 256 * i); bb4[i] = *(const float4*)(b + lane * 4 + 256 * i); }
  const int stride = gridDim.x * 4;
  for (int m0r = blockIdx.x * 4 + wid; m0r < MT_ROWS; m0r += 2 * stride) {
    float4 v[2][4], sh4[2][4], sc4[2][4];
#pragma unroll
    for (int rr = 0; rr < 2; ++rr) {
      const int m = m0r + rr * stride;
      if (m < MT_ROWS) {
        auto md = mods + ((size_t)lm * 3 + cond_idx(m)) * 9216 + (size_t)mi * 1024;
#pragma unroll
        for (int i = 0; i < 4; ++i) v[rr][i] = *(const float4*)(x + (size_t)m * 1024 + lane * 4 + 256 * i);
#pragma unroll
        for (int i = 0; i < 4; ++i) { sh4[rr][i] = *(const float4*)(md + lane * 4 + 256 * i); sc4[rr][i] = *(const float4*)(md + 1024 + lane * 4 + 256 * i); }
        if (m >= 8192) {
          GCF xd = (GCF)(p.ws + W_XD) + (size_t)(m - 8192) * 1024;
#pragma unroll
          for (int i = 0; i < 4; ++i) { float4 e = *(const float4*)(xd + lane * 4 + 256 * i); v[rr][i].x += e.x; v[rr][i].y += e.y; v[rr][i].z += e.z; v[rr][i].w += e.w; }
        }
      }
    }
#pragma unroll
    for (int rr = 0; rr < 2; ++rr) {
      const int m = m0r + rr * stride;
      if (m < MT_ROWS) {
        float s = 0.f;
#pragma unroll
        for (int i = 0; i < 4; ++i) s += v[rr][i].x + v[rr][i].y + v[rr][i].z + v[rr][i].w;
        float mu = wave_sum(s) * (1.f / 1024.f);
        float q = 0.f;
#pragma unroll
        for (int i = 0; i < 4; ++i) { float a = v[rr][i].x - mu, bb = v[rr][i].y - mu, c = v[rr][i].z - mu, d = v[rr][i].w - mu; q += a * a + bb * bb + c * c + d * d; }
        float rstd = rsqrtf(wave_sum(q) * (1.f / 1024.f) + 1e-5f);
#pragma unroll
        for (int i = 0; i < 4; ++i) {
          int c = lane * 4 + 256 * i;
          float4 gg = gg4[i], bb = bb4[i];
          float4 o;
          o.x = (v[rr][i].x - mu) * rstd * gg.x + bb.x; o.y = (v[rr][i].y - mu) * rstd * gg.y + bb.y;
          o.z = (v[rr][i].z - mu) * rstd * gg.z + bb.z; o.w = (v[rr][i].w - mu) * rstd * gg.w + bb.w;
          if (last) { *(float4*)(OUTP + O_Y + (size_t)m * 1024 + c) = o; }
          else {
            *(float4*)(x + (size_t)m * 1024 + c) = o;
            float4 sh = sh4[rr][i], sc = sc4[rr][i];
            uint2 w; w.x = pack2(o.x * (1.f + sc.x) + sh.x, o.y * (1.f + sc.y) + sh.y); w.y = pack2(o.z * (1.f + sc.z) + sh.z, o.w * (1.f + sc.w) + sh.w);
            *(uint2*)(h + (size_t)m * LDH + c) = w;
          }
        }
      }
    }
  }
}

enum { EPI_ACT = 0, EPI_RES, EPI_PROJ, EPI_Q, EPI_KV, EPI_LW, EPI_LA, EPI_LG, EPI_RESD };
struct EpiArg { int l; int gidx; float gs; };

template <int EPI>
DEV void gemm_tile(const P& p, GCU A, int lda, GCU Bt, int ldb, int K,
                                       int m0, int n0, EpiArg ea, char* smem) {
  const int tid = tid_(), lane = tid & 63, wid = tid >> 6, wr = wid >> 1, wc = wid & 1, fr = lane & 15, fq = lane >> 4;
  f32x4 acc[4][4];
#pragma unroll
  for (int i = 0; i < 4; ++i)
#pragma unroll
    for (int j = 0; j < 4; ++j) acc[i][j] = (f32x4){0.f, 0.f, 0.f, 0.f};
  const int lrow = tid >> 3, lpos = tid & 7, gch = lpos ^ ((lrow >> 1) & 7);
  GCU Ag = A + (size_t)(m0 + lrow) * lda + gch * 8;
  GCU Bg = Bt + (size_t)(n0 + lrow) * ldb + gch * 8;
  typedef __attribute__((address_space(3))) unsigned* lds_u;
#define G_ISSUE(stage_, koff) do { \
    char* sb_ = smem + (stage_) * 32768 + wid * 1024; \
    _Pragma("unroll") for (int i = 0; i < 4; ++i) { \
      __builtin_amdgcn_global_load_lds((const AS1 unsigned*)(Ag + (size_t)(32 * i) * lda + (koff)), (lds_u)(sb_ + i * 4096), 16, 0, 0); \
      __builtin_amdgcn_global_load_lds((const AS1 unsigned*)(Bg + (size_t)(32 * i) * ldb + (koff)), (lds_u)(sb_ + 16384 + i * 4096), 16, 0, 0); } } while (0)
  const int nk = K >> 6;
  float xpre[EPI == EPI_RES ? 64 : 1], gpre[4];
  if (EPI == EPI_RES) {
    GCF xq = (GCF)(p.ws + W_X) + (size_t)(m0 + wr * 64 + fq * 4) * 1024 + n0 + wc * 64 + fr;
#pragma unroll
    for (int mi = 0; mi < 4; ++mi)
#pragma unroll
      for (int j = 0; j < 4; ++j)
#pragma unroll
        for (int ni = 0; ni < 4; ++ni) xpre[(mi * 4 + j) * 4 + ni] = xq[(size_t)(mi * 16 + j) * 1024 + ni * 16];
    GCF mq = (GCF)(p.ws + W_MODS) + ((size_t)ea.l * 3 + cond_idx(m0)) * 9216 + (size_t)ea.gidx * 1024 + n0 + wc * 64 + fr;
#pragma unroll
    for (int ni = 0; ni < 4; ++ni) gpre[ni] = mq[ni * 16] * ea.gs;
  }
  __syncthreads();
  G_ISSUE(0, 0);
  asm volatile("s_waitcnt vmcnt(0)" ::: "memory");
  __syncthreads();
  const int sw = (fr >> 1) & 7;
  for (int kt = 0; kt < nk; ++kt) {
    const int buf = kt & 1;
    if (kt + 1 < nk) G_ISSUE(buf ^ 1, (kt + 1) * 64);
    const char* as = smem + buf * 32768 + (wr * 64 + fr) * 128;
    const char* bs = smem + buf * 32768 + 16384 + (wc * 64 + fr) * 128;
#pragma unroll
    for (int ks = 0; ks < 2; ++ks) {
      const int co = ((ks * 4 + fq) ^ sw) * 16;
      bf16x8 af[4], bfr[4];
#pragma unroll
      for (int i = 0; i < 4; ++i) { af[i] = *(const bf16x8*)(as + i * 2048 + co); bfr[i] = *(const bf16x8*)(bs + i * 2048 + co); }
      __builtin_amdgcn_s_setprio(1);
#pragma unroll
      for (int i = 0; i < 4; ++i)
#pragma unroll
        for (int j = 0; j < 4; ++j) acc[i][j] = __builtin_amdgcn_mfma_f32_16x16x32_bf16(af[i], bfr[j], acc[i][j], 0, 0, 0);
      __builtin_amdgcn_s_setprio(0);
      __builtin_amdgcn_sched_barrier(0);
    }
    asm volatile("s_waitcnt vmcnt(0)" ::: "memory");
    __syncthreads();
  }
#undef G_ISSUE
  const int rbase = m0 + wr * 64 + fq * 4, cbase = n0 + wc * 64 + fr;
  if (EPI == EPI_ACT) {
    GU act = (GU)(p.ws + W_BIG);
#pragma unroll
    for (int mi = 0; mi < 4; ++mi)
#pragma unroll
      for (int j = 0; j < 4; ++j) {
        int row = rbase + mi * 16 + j;
#pragma unroll
        for (int ni = 0; ni < 2; ++ni) {
          float g = acc[mi][ni][j], u = acc[mi][ni + 2][j];
          act[(size_t)row * LDF + (n0 >> 1) + wc * 32 + ni * 16 + fr] = f2bf(siluf_(g) * u);
        }
        __builtin_amdgcn_sched_barrier(0);
      }
  } else if (EPI == EPI_RES) {
    GF x = (GF)(p.ws + W_X);
#pragma unroll
    for (int mi = 0; mi < 4; ++mi) {
#pragma unroll
      for (int j = 0; j < 4; ++j) {
        auto xr = x + (size_t)(rbase + mi * 16 + j) * 1024 + cbase;
#pragma unroll
        for (int ni = 0; ni < 4; ++ni) xr[ni * 16] = ALPHA * xpre[(mi * 4 + j) * 4 + ni] + gpre[ni] * acc[mi][ni][j];
      }
    }
  } else if (EPI == EPI_RESD) {
    GF xd = (GF)(p.ws + W_XD);
    GCF mods = (GCF)(p.ws + W_MODS);
    auto md = mods + ((size_t)ea.l * 3 + cond_idx(m0)) * 9216 + (size_t)ea.gidx * 1024 + cbase;
    float gate[4];
#pragma unroll
    for (int ni = 0; ni < 4; ++ni) gate[ni] = md[ni * 16] * ea.gs;
#pragma unroll
    for (int mi = 0; mi < 4; ++mi) {
#pragma unroll
      for (int j = 0; j < 4; ++j) {
        auto xr = xd + (size_t)(rbase + mi * 16 + j - 8192) * 1024 + cbase;
#pragma unroll
        for (int ni = 0; ni < 4; ++ni) xr[ni * 16] = gate[ni] * acc[mi][ni][j];
      }
      __builtin_amdgcn_sched_barrier(0);
    }
  } else if (EPI == EPI_PROJ) {
    GF pr = (GF)(p.ws + W_BIG);
#pragma unroll
    for (int mi = 0; mi < 4; ++mi) {
#pragma unroll
      for (int j = 0; j < 4; ++j) {
        auto prr = pr + (size_t)(rbase + mi * 16 + j) * PLD + cbase;
#pragma unroll
        for (int ni = 0; ni < 4; ++ni) prr[ni * 16] = acc[mi][ni][j];
      }
      __builtin_amdgcn_sched_barrier(0);
    }
    if (n0 >= C_AW && n0 < C_AW + 384) {
      GU lin = (GU)(p.ws + W_LIN);
      const int kind = (n0 - C_AW) >> 7;
#pragma unroll
      for (int mi = 0; mi < 4; ++mi)
#pragma unroll
        for (int j = 0; j < 4; ++j)
#pragma unroll
          for (int ni = 0; ni < 4; ++ni) {
            float v = acc[mi][ni][j];
            v = kind == 0 ? tanhf_(v) : (kind == 2 ? sigmoidf_(v) : v);
            lin[(size_t)(rbase + mi * 16 + j) * 384 + (cbase - C_AW) + ni * 16] = f2bf(v);
          }
    }
  } else if (EPI == EPI_LW || EPI == EPI_LA) {
    GF dst = (GF)(p.ws + (EPI == EPI_LW ? W_RWW : W_RWA));
    GCF bias = IN(EPI == EPI_LW ? I_RW0 : I_RA0);
#pragma unroll
    for (int ni = 0; ni < 4; ++ni) {
      const int col = cbase + ni * 16, d = col >> 8, jc = col & 255;
      const float b0 = bias[(ea.l * 2 + d) * 256 + jc];
#pragma unroll
      for (int mi = 0; mi < 4; ++mi)
#pragma unroll
        for (int j = 0; j < 4; ++j) {
          const float a = b0 + acc[mi][ni][j];
          float r;
          if (EPI == EPI_LW) { float wl = -softplusf_(-a) - 0.5f; r = __expf(-__expf(wl)); } else r = sigmoidf_(a);
          dst[((size_t)d * MT_ROWS + rbase + mi * 16 + j) * 256 + jc] = r;
        }
    }
  } else if (EPI == EPI_LG) {
    GF dst = (GF)(p.ws + W_RWG);
#pragma unroll
    for (int mi = 0; mi < 4; ++mi)
#pragma unroll
      for (int j = 0; j < 4; ++j)
#pragma unroll
        for (int ni = 0; ni < 4; ++ni) dst[(size_t)(rbase + mi * 16 + j) * 256 + cbase + ni * 16] = acc[mi][ni][j];
  } else if (EPI == EPI_Q) {
    GU qb = (GU)(p.ws + W_QB);
    const bool latent = m0 >= MCTX;
#pragma unroll
    for (int ni = 0; ni < 4; ++ni) {
      const int col = cbase + ni * 16;
      const int ctile = (n0 + wc * 64 + ni * 16) >> 4;
      const int tin = ctile % 6;
      const bool rope = latent && tin >= 4;
      const int i = (tin - 4) * 16 + fr;
      GCF rtab = (GCF)(p.ws + W_ROPE);
#pragma unroll
      for (int mi = 0; mi < 4; ++mi)
#pragma unroll
        for (int j = 0; j < 4; ++j) {
          const int row = rbase + mi * 16 + j;
          float v = acc[mi][ni][j];
          if (rope) {
            float pv = __shfl_xor(v, 8, 64);
            int t = (row - MCTX) & 4095;
            float cs = rtab[(t * 32 + i) * 2], sn = rtab[(t * 32 + i) * 2 + 1];
            v = (i & 8) ? (v * cs + pv * sn) : (v * cs - pv * sn);
          }
          qb[(size_t)row * 384 + col] = f2bf(v * QSCALE);
        }
    }
  } else if (EPI == EPI_KV) {
    GU kb = (GU)(p.ws + W_KB);
    GU vt = (GU)(p.ws + W_VT);
#pragma unroll
    for (int ni = 0; ni < 4; ++ni) {
      const int col = cbase + ni * 16, head = col >> 7, dd = col & 127;
#pragma unroll
      for (int mi = 0; mi < 4; ++mi) {
        const int row = rbase + mi * 16;
        if (dd < 64) {
#pragma unroll
          for (int j = 0; j < 4; ++j) kb[((size_t)(row + j) * 4 + head) * 96 + dd] = f2bf(acc[mi][ni][j]);
        } else {
          uint2 w; w.x = pack2(acc[mi][ni][0], acc[mi][ni][1]); w.y = pack2(acc[mi][ni][2], acc[mi][ni][3]);
          *(uint2*)(vt + (size_t)(head * 64 + dd - 64) * MKV + row) = w;
        }
      }
    }
  }
}

template <int EPI>
DEV void gemm_phase(const P& p, GCU A, int lda, GCU Bt, int ldb, int K, int MT, int NT, EpiArg ea, char* smem) {
  const int xcd = blockIdx.x & 7, slot = blockIdx.x >> 3, spx = gridDim.x >> 3;
  const int sbM = (MT + 7) >> 3, sbN = (NT + 7) >> 3, nsb = sbM * sbN;
  for (int sb = xcd; sb < nsb; sb += 8) {
    const int sm = sb % sbM, sn = sb / sbM;
    for (int idx = slot; idx < 64; idx += spx) {
      const int mt = sm * 8 + (idx & 7), nt = sn * 8 + (idx >> 3);
      if (mt < MT && nt < NT) gemm_tile<EPI>(p, A, lda, Bt, ldb, K, mt * 128, nt * 128, ea, smem);
    }
  }
}

DEV void gemm_res_phase(const P& p, GCU A, int lda, GCU Bt, int ldb, int K, EpiArg ea, char* smem) {
  const int xcd = blockIdx.x & 7, slot = blockIdx.x >> 3, spx = gridDim.x >> 3;
  for (int idx = slot; idx < 64; idx += spx) gemm_tile<EPI_RES>(p, A, lda, Bt, ldb, K, (xcd * 8 + (idx & 7)) * 128, (idx >> 3) * 128, ea, smem);
  const int sb = 8 + (xcd >> 1), kh = xcd & 1, Kh = K >> 1;
  for (int idx = slot; idx < 64; idx += spx) {
    const int m0 = (sb * 8 + (idx & 7)) * 128, n0 = (idx >> 3) * 128;
    if (kh == 0) gemm_tile<EPI_RES>(p, A, lda, Bt, ldb, Kh, m0, n0, ea, smem);
    else gemm_tile<EPI_RESD>(p, A + Kh, lda, Bt + Kh, ldb, Kh, m0, n0, ea, smem);
  }
}

DEV void rwkv_prep_item(const P& p, int l, int tile, char* smem) {
  GCF proj = (GCF)(p.ws + W_BIG);
  GF rwkk = (GF)(p.ws + W_RWKK);
  const int tid = tid_(), m0 = tile * 32, j = tid;
  const float kkp = IN(I_RKK)[l * 256 + j];
#pragma unroll
  for (int tb = 0; tb < 2; ++tb) {
    float kv[16];
#pragma unroll
    for (int i = 0; i < 16; ++i) kv[i] = proj[(size_t)(m0 + tb * 16 + i) * PLD + C_AK + j] * kkp;
#pragma unroll
    for (int i = 0; i < 16; ++i) {
      float ss = wave_sum(kv[i] * kv[i]);
      rwkk[(size_t)(m0 + tb * 16 + i) * 256 + j] = kv[i] / fmaxf(sqrtf(ss), 1e-12f);
    }
  }
}

DEV void rg_prep_item(const P& p, int l, int tile, char* smem) {
  typedef __attribute__((ext_vector_type(16))) float f32x16;
  float* us = (float*)smem;
  u16* ub = (u16*)(smem + 32768);
  GCF proj = (GCF)(p.ws + W_BIG);
  const int tid = tid_(), m0 = tile * 32, j = tid, g = tid >> 6, lane = tid & 63, l32 = lane & 31, lh = lane >> 5;
  const int s = m0 < MCTX ? (m0 >> 8) : 16 + ((m0 - MCTX) >> 12);
  const int r0 = seq_row0(s), T = seq_len(s);
  {
    const float cw0 = IN(I_CVW)[(l * 4 + 0) * 256 + j], cw1 = IN(I_CVW)[(l * 4 + 1) * 256 + j],
                cw2 = IN(I_CVW)[(l * 4 + 2) * 256 + j], cw3 = IN(I_CVW)[(l * 4 + 3) * 256 + j], cb = IN(I_CVB)[l * 256 + j];
    const int tb = m0 - r0;
    float xv[35];
#pragma unroll
    for (int i = 0; i < 35; ++i) { int t = tb + i - 2; xv[i] = (t >= 0 && t < T) ? proj[(size_t)(r0 + t) * PLD + C_CX + j] : 0.f; }
#pragma unroll
    for (int tok = 0; tok < 32; ++tok) {
      float u = cb + cw0 * xv[tok] + cw1 * xv[tok + 1] + cw2 * xv[tok + 2] + cw3 * xv[tok + 3];
      us[tok * 256 + j] = u; ub[tok * 264 + j] = f2bf(u);
    }
  }
  __syncthreads();
  GF rga = (GF)(p.ws + W_RGA); GF rgb = (GF)(p.ws + W_RGB);
  GF rgta = (GF)(p.ws + W_RGTA); GF rgtb = (GF)(p.ws + W_RGTB);
  bf16x8 af[4];
#pragma unroll
  for (int ks = 0; ks < 4; ++ks) af[ks] = *(const bf16x8*)(ub + l32 * 264 + g * 64 + ks * 16 + lh * 8);
#pragma unroll 1
  for (int dn = 0; dn < 4; ++dn) {
    const int d = dn >> 1, nb = dn & 1;
    f32x16 cr, ci;
#define RG_GATE(WIDX_, D_) do { \
      auto W = IN(WIDX_) + ((size_t)((l * 2 + d) * 4 + g)) * 4096; \
      _Pragma("unroll") for (int r = 0; r < 16; ++r) D_[r] = 0.f; \
      float wv[32]; \
      _Pragma("unroll") for (int ks = 0; ks < 4; ++ks) \
        _Pragma("unroll") for (int jj = 0; jj < 8; ++jj) wv[ks * 8 + jj] = W[(ks * 16 + lh * 8 + jj) * 64 + nb * 32 + l32]; \
      _Pragma("unroll") for (int ks = 0; ks < 4; ++ks) { \
        uint4 pw = make_uint4(pack2(wv[ks * 8 + 0], wv[ks * 8 + 1]), pack2(wv[ks * 8 + 2], wv[ks * 8 + 3]), pack2(wv[ks * 8 + 4], wv[ks * 8 + 5]), pack2(wv[ks * 8 + 6], wv[ks * 8 + 7])); \
        bf16x8 bfr = __builtin_bit_cast(bf16x8, pw); \
        D_ = __builtin_amdgcn_mfma_f32_32x32x16_bf16(af[ks], bfr, D_, 0, 0, 0); \
      } } while (0)
    RG_GATE(I_GWA, cr);
    RG_GATE(I_GWX, ci);
#undef RG_GATE
    {
      const int ch = g * 64 + nb * 32 + l32;
      const float ba = IN(I_GBA)[(l * 2 + d) * 256 + ch], bx = IN(I_GBX)[(l * 2 + d) * 256 + ch];
      const float spl = softplusf_(-IN(I_GLAM)[(l * 2 + d) * 256 + ch]);
      float sA[4], sB[4];
#pragma unroll
      for (int q = 0; q < 4; ++q) {
        float cA = 1.f, cB = 0.f;
#pragma unroll
        for (int rr = 0; rr < 4; ++rr) {
          const int r = q * 4 + rr, tok = 8 * q + 4 * lh + rr;
          const float rg = sigmoidf_(cr[r] + ba), ig = sigmoidf_(ci[r] + bx);
          const float la = -8.f * rg * spl;
          const float av = __expf(la);
          const float bv = sqrtf(fmaxf(1.f - av * av, 0.f)) * (ig * us[tok * 256 + ch]);
          rga[((size_t)d * MT_ROWS + m0 + tok) * 256 + ch] = av;
          rgb[((size_t)d * MT_ROWS + m0 + tok) * 256 + ch] = bv;
          if (d == 0) { cB = cB * av + bv; cA = cA * av; } else { cB = cB + cA * bv; cA = cA * av; }
        }
        sA[q] = cA; sB[q] = cB;
      }
      float oA[4], oB[4];
#pragma unroll
      for (int q = 0; q < 4; ++q) { oA[q] = __shfl_xor(sA[q], 32, 64); oB[q] = __shfl_xor(sB[q], 32, 64); }
      float cA = 1.f, cB = 0.f;
#pragma unroll
      for (int q8 = 0; q8 < 8; ++q8) {
        const bool mine = (q8 & 1) == lh;
        const float a_ = mine ? sA[q8 >> 1] : oA[q8 >> 1], b_ = mine ? sB[q8 >> 1] : oB[q8 >> 1];
        if (d == 0) { cB = cB * a_ + b_; cA = cA * a_; } else { cB = cB + cA * b_; cA = cA * a_; }
      }
      if (lh == 0) { rgta[((size_t)d * 384 + tile) * 256 + ch] = cA; rgtb[((size_t)d * 384 + tile) * 256 + ch] = cB; }
    }
  }
}

DEV void mla_prep_item(const P& p, int l, int item) {
  GCF proj = (GCF)(p.ws + W_BIG);
  GU cqn = (GU)(p.ws + W_CQN); GU ckvn = (GU)(p.ws + W_CKVN); GU kb = (GU)(p.ws + W_KB);
  const int lane = tid_() & 63, wid = tid_() >> 6;
  for (int r = 0; r < 16; ++r) {
    const int m = item * 64 + wid * 16 + r;
    if (m < MT_ROWS) {
      auto pr = proj + (size_t)m * PLD;
      float4 q = *(const float4*)(pr + C_BQ + lane * 4);
      float ss = wave_sum(q.x * q.x + q.y * q.y + q.z * q.z + q.w * q.w);
      float rs = rsqrtf(ss * (1.f / 256.f) + 1e-6f);
      float4 g = *(const float4*)(IN(I_QNG) + l * 256 + lane * 4);
      uint2 w; w.x = pack2(q.x * rs * g.x, q.y * rs * g.y); w.y = pack2(q.z * rs * g.z, q.w * rs * g.w);
      *(uint2*)(cqn + (size_t)m * 256 + lane * 4) = w;
      float2 c = *(const float2*)(pr + C_BKV + lane * 2);
      float s2 = wave_sum(c.x * c.x + c.y * c.y);
      float r2 = rsqrtf(s2 * (1.f / 128.f) + 1e-6f);
      float2 g2 = *(const float2*)(IN(I_KVNG) + l * 128 + lane * 2);
      float c0 = c.x * r2 * g2.x, c1 = c.y * r2 * g2.y;
      *(unsigned*)(ckvn + (size_t)m * 128 + lane * 2) = pack2(c0, c1);
      float pe = pr[C_BPE + (lane & 31)];
      float ppe = __shfl_xor(pe, 8, 64);
      float kv = pe;
      if (m < MCTX) {
        int b = m >> 8, t = m & 255;
        *(float2*)(OUTP + O_CKV + (((size_t)b * 4 + l) * 256 + t) * 128 + lane * 2) = make_float2(c0, c1);
        if (lane < 32) OUTP[O_KPE + (((size_t)b * 4 + l) * 256 + t) * 32 + lane] = pe;
      } else {
        int i = lane & 31, t = (m - MCTX) & 4095;
        float cs = ((GCF)(p.ws + W_ROPE))[(t * 32 + i) * 2], sn = ((GCF)(p.ws + W_ROPE))[(t * 32 + i) * 2 + 1];
        kv = (i & 8) ? (pe * cs + ppe * sn) : (pe * cs - ppe * sn);
      }
      if (lane < 32) {
        u16 kb16 = f2bf(kv);
#pragma unroll
        for (int hh = 0; hh < 4; ++hh) kb[((size_t)m * 4 + hh) * 96 + 64 + lane] = kb16;
      }
    } else {
      const int cr = m - MT_ROWS, b = cr >> 9, pp = cr & 511;
      float2 c = *(const float2*)(IN(I_CCKV) + (((size_t)b * 4 + l) * 512 + pp) * 128 + lane * 2);
      *(unsigned*)(ckvn + (size_t)m * 128 + lane * 2) = pack2(c.x, c.y);
      if (lane < 32) {
        u16 kb16 = f2bf(IN(I_CKPE)[(((size_t)b * 4 + l) * 512 + pp) * 32 + lane]);
#pragma unroll
        for (int hh = 0; hh < 4; ++hh) kb[((size_t)m * 4 + hh) * 96 + 64 + lane] = kb16;
      }
    }
  }
}

DEV void hg_decode(int item, int& s, int& c, int& d, int& h) {
  h = item & 3; d = (item >> 2) & 1; int ch = item >> 3;
  if (ch < 64) { s = ch >> 2; c = ch & 3; } else { s = 16 + ((ch - 64) >> 6); c = (ch - 64) & 63; }
}
template <bool WITHQ, int N>
DEV void hg_stage(const P& p, int l, int s, int d, int h, int i0, float* gs, float* vs, float* qs) {
  GCF proj = (GCF)(p.ws + W_BIG);
  GCF lbs = (GCF)(p.ws + W_LBS) + (l * 2 + d) * 256 + h * 64;
  const int r0 = seq_row0(s), T = seq_len(s), tid = tid_();
  const int k = tid & 63;
  const float lb = lbs[k];
  constexpr int NI = N / 4;
  float xf[NI], xv[NI], xq[NI];
#pragma unroll
  for (int u = 0; u < NI; ++u) {
    int i = (tid >> 6) + 4 * u;
    int t = d ? (T - 1 - (i0 + i)) : (i0 + i);
    auto pr = proj + (size_t)(r0 + t) * PLD;
    xf[u] = pr[C_DF + d * 256 + h * 64 + k]; xv[u] = pr[C_DI + h * 64 + k];
    if (WITHQ) xq[u] = pr[C_DQ + h * 64 + k];
  }
#pragma unroll
  for (int u = 0; u < NI; ++u) {
    int idx = ((tid >> 6) + 4 * u) * 64 + k;
    gs[idx] = lb + (1.f - lb) * sigmoidf_(xf[u]);
    vs[idx] = xv[u];
    if (WITHQ) qs[idx] = siluf_(xq[u]);
  }
}
DEV void hgrn_a_item(const P& p, int l, int item, char* smem) {
  typedef __attribute__((ext_vector_type(16))) float f32x16;
  float* gs = (float*)smem; float* vs = gs + 4096;
  float* part = vs + 4096;
  u16* wT = (u16*)(part + 256);
  u16* vT = wT + 64 * 72;
  int s, c, d, h; hg_decode(item, s, c, d, h);
  hg_stage<false, 64>(p, l, s, d, h, c * 64, gs, vs, nullptr);
  __syncthreads();
  const int tid = tid_(), k = tid & 63, qt = tid >> 6, lane = tid & 63, l32 = lane & 31, lh = lane >> 5;
  float lg[16], gk[16], loc = 0.f;
  unsigned vp[8];
#pragma unroll
  for (int u = 0; u < 16; ++u) { gk[u] = gs[(qt * 16 + u) * 64 + k]; lg[u] = __logf(fmaxf(gk[u], 1e-30f)); loc += lg[u]; }
#pragma unroll
  for (int u = 0; u < 8; ++u) vp[u] = pack2(vs[(qt * 16 + 2 * u) * 64 + k], vs[(qt * 16 + 2 * u + 1) * 64 + k]);
  part[qt * 64 + k] = loc;
  *(uint4*)(vT + k * 72 + qt * 16) = make_uint4(vp[0], vp[1], vp[2], vp[3]);
  *(uint4*)(vT + k * 72 + qt * 16 + 8) = make_uint4(vp[4], vp[5], vp[6], vp[7]);
  __syncthreads();
  float pre = 0.f, tot = 0.f;
#pragma unroll
  for (int q = 0; q < 4; ++q) { const float pv = part[q * 64 + k]; if (q < qt) pre += pv; tot += pv; }
  float run = pre;
  unsigned wp[8];
#pragma unroll
  for (int u = 0; u < 8; ++u) {
    run += lg[2 * u]; const float w0 = (1.f - gk[2 * u]) * __expf(tot - run);
    run += lg[2 * u + 1]; const float w1 = (1.f - gk[2 * u + 1]) * __expf(tot - run);
    wp[u] = pack2(w0, w1);
  }
  *(uint4*)(wT + k * 72 + qt * 16) = make_uint4(wp[0], wp[1], wp[2], wp[3]);
  *(uint4*)(wT + k * 72 + qt * 16 + 8) = make_uint4(wp[4], wp[5], wp[6], wp[7]);
  GF hS = (GF)(p.ws + W_HGS) + (size_t)item * 4096;
  GF hD = (GF)(p.ws + W_HGD) + (size_t)item * 64;
  if (qt == 0) hD[k] = __expf(tot);
  __syncthreads();
  const int kb = qt >> 1, vb = qt & 1;
  f32x16 acc;
#pragma unroll
  for (int r = 0; r < 16; ++r) acc[r] = 0.f;
#pragma unroll
  for (int ks = 0; ks < 4; ++ks) {
    const bf16x8 af = *(const bf16x8*)(wT + (kb * 32 + l32) * 72 + ks * 16 + lh * 8);
    const bf16x8 bfr = *(const bf16x8*)(vT + (vb * 32 + l32) * 72 + ks * 16 + lh * 8);
    acc = __builtin_amdgcn_mfma_f32_32x32x16_bf16(af, bfr, acc, 0, 0, 0);
  }
#pragma unroll
  for (int r = 0; r < 16; ++r) hS[(kb * 32 + (r & 3) + 8 * (r >> 2) + 4 * lh) * 64 + vb * 32 + l32] = acc[r];
}
DEV void hgrn_b_item(const P& p, int l, int item) {
  GF hS = (GF)(p.ws + W_HGS); GCF hD = (GCF)(p.ws + W_HGD);
  if (item < 128) {
    const int combo = item, s = combo >> 3, d = (combo >> 2) & 1, h = combo & 3, ch0 = s * 4;
#pragma unroll 1
    for (int ub = 0; ub < 4; ++ub) {
      float t[4][4], dd[4][4];
#pragma unroll
      for (int uu = 0; uu < 4; ++uu) {
        const int e = (ub * 4 + uu) * 256 + tid_();
#pragma unroll
        for (int u = 0; u < 4; ++u) { int it = ((ch0 + u) * 2 + d) * 4 + h; t[uu][u] = hS[(size_t)it * 4096 + e]; dd[uu][u] = hD[(size_t)it * 64 + (e >> 6)]; }
      }
#pragma unroll
      for (int uu = 0; uu < 4; ++uu) {
        const int e = (ub * 4 + uu) * 256 + tid_();
        float S = 0.f;
#pragma unroll
        for (int u = 0; u < 4; ++u) { int it = ((ch0 + u) * 2 + d) * 4 + h; hS[(size_t)it * 4096 + e] = S; S = dd[uu][u] * S + t[uu][u]; }
        OUTP[O_HGRN + ((((size_t)s * 4 + l) * 2 + d) * 4 + h) * 4096 + e] = S;
      }
    }
  } else {
    const int li = item - 128, combo = 128 + (li >> 4), e = (li & 15) * 256 + tid_();
    const int s = combo >> 3, d = (combo >> 2) & 1, h = combo & 3, ch0 = 64 + (s - 16) * 64, k = e >> 6;
    float S = IN(I_SHG)[((((size_t)(s - 16) * 4 + l) * 2 + d) * 4 + h) * 4096 + e];
    for (int c = 0; c < 64; c += 16) {
      float t[16], dd[16];
#pragma unroll
      for (int u = 0; u < 16; ++u) { int it = ((ch0 + c + u) * 2 + d) * 4 + h; t[u] = hS[(size_t)it * 4096 + e]; dd[u] = hD[(size_t)it * 64 + k]; }
#pragma unroll
      for (int u = 0; u < 16; ++u) { int it = ((ch0 + c + u) * 2 + d) * 4 + h; hS[(size_t)it * 4096 + e] = S; S = dd[u] * S + t[u]; }
    }
  }
}
DEV void hgrn_c_item(const P& p, int l, int item, char* smem) {
  float* gs = (float*)smem; float* vs = gs + 2048; float* qs = vs + 2048; float* part = qs + 2048;
  int s, c, d, h; hg_decode(item, s, c, d, h);
  const int tid = tid_(), v = tid & 63, kg = tid >> 6;
  GCF hS = (GCF)(p.ws + W_HGS2) + (size_t)item * 4096;
  GF hgo = (GF)(p.ws + W_HGO);
  const int r0 = seq_row0(s), T = seq_len(s);
  f2_ S[8];
#pragma unroll
  for (int j = 0; j < 8; ++j) { S[j].x = hS[(kg * 16 + 2 * j) * 64 + v]; S[j].y = hS[(kg * 16 + 2 * j + 1) * 64 + v]; }
  for (int half = 0; half < 2; ++half) {
    __syncthreads();
    hg_stage<true, 32>(p, l, s, d, h, c * 64 + half * 32, gs, vs, qs);
    __syncthreads();
#pragma unroll 4
    for (int i = 0; i < 32; ++i) {
      const float vv = vs[i * 64 + v];
      const f2_ vv2 = {vv, vv};
      f2_ o2 = {0.f, 0.f};
#pragma unroll
      for (int j4 = 0; j4 < 4; ++j4) {
        float4 g4 = *(const float4*)(gs + i * 64 + kg * 16 + j4 * 4);
        float4 q4 = *(const float4*)(qs + i * 64 + kg * 16 + j4 * 4);
        const f2_ ga = {g4.x, g4.y}, gb = {g4.z, g4.w}, qa = {q4.x, q4.y}, qb_ = {q4.z, q4.w};
        S[j4 * 2] = ga * (S[j4 * 2] - vv2) + vv2; o2 += qa * S[j4 * 2];
        S[j4 * 2 + 1] = gb * (S[j4 * 2 + 1] - vv2) + vv2; o2 += qb_ * S[j4 * 2 + 1];
      }
      part[(i * 4 + kg) * 64 + v] = o2.x + o2.y;
    }
    __syncthreads();
#pragma unroll
    for (int r = 0; r < 8; ++r) {
      int i = (tid >> 6) + 4 * r;
      float o = part[(i * 4 + 0) * 64 + v] + part[(i * 4 + 1) * 64 + v] + part[(i * 4 + 2) * 64 + v] + part[(i * 4 + 3) * 64 + v];
      int fi = c * 64 + half * 32 + i;
      int t = d ? (T - 1 - fi) : fi;
      hgo[((size_t)d * MT_ROWS + r0 + t) * 256 + h * 64 + v] = o;
    }
  }
}

DEV float geluf_(float x) { return 0.5f * x * (1.f + tanhf(0.7978845608028654f * (x + 0.044715f * x * x * x))); }
DEV void rg_scan_item(const P& p, int l, int tile, char* smem) {
  float* hf = (float*)smem;
  GCF proj = (GCF)(p.ws + W_BIG);
  GCF rga = (GCF)(p.ws + W_RGA); GCF rgb = (GCF)(p.ws + W_RGB);
  GCF rgta = (GCF)(p.ws + W_RGTA); GCF rgtb = (GCF)(p.ws + W_RGTB);
  GU mix = (GU)(p.ws + W_MIX);
  const int j = tid_(), m0 = tile * 32;
  const int s = m0 < MCTX ? (m0 >> 8) : 16 + ((m0 - MCTX) >> 12);
  const int t0 = seq_row0(s) >> 5, nt = seq_len(s) >> 5;
  float h = 0.f;
  if (s >= 16) h = IN(I_SRG)[(((size_t)(s - 16) * 4 + l) * 2 + 0) * 256 + j];
  {
    int tq = t0;
    for (; tq + 16 <= tile; tq += 16) {
      float ca[16], cb_[16];
#pragma unroll
      for (int u = 0; u < 16; ++u) { ca[u] = rgta[(size_t)(tq + u) * 256 + j]; cb_[u] = rgtb[(size_t)(tq + u) * 256 + j]; }
#pragma unroll
      for (int u = 0; u < 16; ++u) h = ca[u] * h + cb_[u];
    }
    for (; tq + 4 <= tile; tq += 4) {
      float ca[4], cb_[4];
#pragma unroll
      for (int u = 0; u < 4; ++u) { ca[u] = rgta[(size_t)(tq + u) * 256 + j]; cb_[u] = rgtb[(size_t)(tq + u) * 256 + j]; }
#pragma unroll
      for (int u = 0; u < 4; ++u) h = ca[u] * h + cb_[u];
    }
    for (; tq < tile; ++tq) h = rgta[(size_t)tq * 256 + j] * h + rgtb[(size_t)tq * 256 + j];
  }
  {
    float av[32], bv[32];
#pragma unroll
    for (int tok = 0; tok < 32; ++tok) { size_t o = (size_t)(m0 + tok) * 256 + j; av[tok] = rga[o]; bv[tok] = rgb[o]; }
#pragma unroll
    for (int tok = 0; tok < 32; ++tok) { h = av[tok] * h + bv[tok]; hf[tok * 256 + j] = h; }
  }
  if (s < 16 && tile == t0 + nt - 1) OUTP[O_RGLRU + (((size_t)s * 4 + l) * 2 + 0) * 256 + j] = h;
  h = 0.f;
  if (s >= 16) h = IN(I_SRG)[(((size_t)(s - 16) * 4 + l) * 2 + 1) * 256 + j];
  {
    int tq = t0 + nt - 1;
    for (; tq - 16 >= tile; tq -= 16) {
      float ca[16], cb_[16];
#pragma unroll
      for (int u = 0; u < 16; ++u) { ca[u] = rgta[((size_t)384 + tq - u) * 256 + j]; cb_[u] = rgtb[((size_t)384 + tq - u) * 256 + j]; }
#pragma unroll
      for (int u = 0; u < 16; ++u) h = ca[u] * h + cb_[u];
    }
    for (; tq - 4 >= tile; tq -= 4) {
      float ca[4], cb_[4];
#pragma unroll
      for (int u = 0; u < 4; ++u) { ca[u] = rgta[((size_t)384 + tq - u) * 256 + j]; cb_[u] = rgtb[((size_t)384 + tq - u) * 256 + j]; }
#pragma unroll
      for (int u = 0; u < 4; ++u) h = ca[u] * h + cb_[u];
    }
    for (; tq > tile; --tq) h = rgta[((size_t)384 + tq) * 256 + j] * h + rgtb[((size_t)384 + tq) * 256 + j];
  }
  {
    float av[32], bv[32], gt[32];
#pragma unroll
    for (int tok = 0; tok < 32; ++tok) { size_t o = ((size_t)MT_ROWS + m0 + tok) * 256 + j; av[tok] = rga[o]; bv[tok] = rgb[o]; gt[tok] = proj[(size_t)(m0 + tok) * PLD + C_CG + j]; }
#pragma unroll
    for (int tok = 31; tok >= 0; --tok) {
      h = av[tok] * h + bv[tok];
      mix[(size_t)(m0 + tok) * LDH + 512 + j] = f2bf((hf[tok * 256 + j] + h) * geluf_(gt[tok]));
    }
  }
  if (s < 16 && tile == t0) OUTP[O_RGLRU + (((size_t)s * 4 + l) * 2 + 1) * 256 + j] = h;
}

DEV void rwkv_scan_item(const P& p, int l, int s, int d, int h, int c, int nch, int g, char* smem) {
  float* buf = (float*)smem;
  float* opart = buf + 2 * 6144;
  GCF proj = (GCF)(p.ws + W_BIG);
  GCF rww = (GCF)(p.ws + W_RWW) + (size_t)d * MT_ROWS * 256;
  GCF rwa = (GCF)(p.ws + W_RWA) + (size_t)d * MT_ROWS * 256;
  GCF rwkk = (GCF)(p.ws + W_RWKK);
  const int tid = tid_(), lane = tid & 63, wid = tid >> 6, e = lane & 15;
  const bool isP = g >= 4;
  const int rowbase = (g & 3) * 16, rl = wid * 4 + (lane >> 4), row = rowbase + rl;
  const int r0 = seq_row0(s), T = seq_len(s), CL = T / nch, nck = CL >> 4, i0 = c * CL;
  auto outp = isP ? (GF)(p.ws + W_RWU) + ((size_t)d * 8192 - MCTX) * 256 : (GF)(p.ws + W_RWO) + (size_t)d * MT_ROWS * 256;
  const int lstep = tid >> 4, lq = (tid & 15) * 4, col = h * 64 + lq;
  const float4 ka4 = *(const float4*)(IN(I_RKA) + l * 256 + col);
  f2_ S01 = {0.f, 0.f}, S23 = {0.f, 0.f};
  if (isP) { S01.x = (e * 4 + 0 == row) ? 1.f : 0.f; S01.y = (e * 4 + 1 == row) ? 1.f : 0.f; S23.x = (e * 4 + 2 == row) ? 1.f : 0.f; S23.y = (e * 4 + 3 == row) ? 1.f : 0.f; }
  else if (c == 0 && s >= 16) {
    float4 st = *(const float4*)(IN(I_SRWKV) + ((((size_t)(s - 16) * 4 + l) * 2 + d) * 4 + h) * 4096 + row * 64 + e * 4);
    S01.x = st.x; S01.y = st.y; S23.x = st.z; S23.y = st.w;
  }
  const float vmask = isP ? 0.f : 1.f;
  float4 gr, gk, gv, gw, ga, gkk;
  auto gload = [&](int ck) {
    int ti = i0 + ck * 16 + lstep; int t = d ? (T - 1 - ti) : ti; size_t m = (size_t)(r0 + t);
    gr = *(const float4*)(proj + m * PLD + C_AR + col); gk = *(const float4*)(proj + m * PLD + C_AK + col); gv = *(const float4*)(proj + m * PLD + C_AV + col);
    gw = *(const float4*)(rww + m * 256 + col); ga = *(const float4*)(rwa + m * 256 + col); gkk = *(const float4*)(rwkk + m * 256 + col);
  };
  auto sstore = [&](int b) {
    float* bb = buf + b * 6144 + lstep * 64 + lq;
    float4 kd, kka;
    kd.x = gk.x * (1.f + (ga.x - 1.f) * ka4.x); kd.y = gk.y * (1.f + (ga.y - 1.f) * ka4.y); kd.z = gk.z * (1.f + (ga.z - 1.f) * ka4.z); kd.w = gk.w * (1.f + (ga.w - 1.f) * ka4.w);
    kka.x = gkk.x * ga.x; kka.y = gkk.y * ga.y; kka.z = gkk.z * ga.z; kka.w = gkk.w * ga.w;
    *(float4*)(bb) = gr; *(float4*)(bb + 1024) = gw; *(float4*)(bb + 2048) = kd; *(float4*)(bb + 3072) = gkk; *(float4*)(bb + 4096) = kka; *(float4*)(bb + 5120) = gv;
  };
  __syncthreads();
  gload(0); sstore(0);
  __syncthreads();
  for (int ck = 0; ck < nck; ++ck) {
    const int b = ck & 1;
    if (ck + 1 < nck) gload(ck + 1);
    const float* bb = buf + b * 6144 + e * 4;
    const float* bv = buf + b * 6144 + 5120 + row;
    float4 r4 = *(const float4*)(bb), w4 = *(const float4*)(bb + 1024), kd4 = *(const float4*)(bb + 2048), kk4 = *(const float4*)(bb + 3072), ka_ = *(const float4*)(bb + 4096);
    float vv = bv[0];
#pragma unroll
    for (int st = 0; st < 16; ++st) {
      float4 nr4, nw4, nkd4, nkk4, nka_; float nvv;
      if (st < 15) {
        nr4 = *(const float4*)(bb + (st + 1) * 64); nw4 = *(const float4*)(bb + 1024 + (st + 1) * 64); nkd4 = *(const float4*)(bb + 2048 + (st + 1) * 64);
        nkk4 = *(const float4*)(bb + 3072 + (st + 1) * 64); nka_ = *(const float4*)(bb + 4096 + (st + 1) * 64); nvv = bv[(st + 1) * 64];
      }
      const float vm = vv * vmask;
      const f2_ kk01 = {kk4.x, kk4.y}, kk23 = {kk4.z, kk4.w}, w01 = {w4.x, w4.y}, w23 = {w4.z, w4.w};
      const f2_ kd01 = {kd4.x, kd4.y}, kd23 = {kd4.z, kd4.w}, ka01 = {ka_.x, ka_.y}, ka23 = {ka_.z, ka_.w}, r01 = {r4.x, r4.y}, r23 = {r4.z, r4.w};
      f2_ dp = S01 * kk01 + S23 * kk23;
      const f2_ vm2 = {vm, vm};
      f2_ t01 = S01 * w01 + vm2 * kd01, t23 = S23 * w23 + vm2 * kd23;
      float pp = row16_sum(dp.x + dp.y);
      const f2_ pp2 = {pp, pp};
      S01 = t01 - pp2 * ka01; S23 = t23 - pp2 * ka23;
      f2_ od = S01 * r01 + S23 * r23;
      opart[(st * 16 + rl) * 16 + e] = od.x + od.y;
      if (st < 15) { r4 = nr4; w4 = nw4; kd4 = nkd4; kk4 = nkk4; ka_ = nka_; vv = nvv; }
    }
    {
      const int ost = lane >> 2, orr = lane & 3;
      const float* op = opart + ((ost * 16 + wid * 4 + orr) * 16);
      float4 a0 = *(const float4*)(op), a1 = *(const float4*)(op + 4), a2 = *(const float4*)(op + 8), a3 = *(const float4*)(op + 12);
      float o = ((a0.x + a0.y) + (a0.z + a0.w)) + ((a1.x + a1.y) + (a1.z + a1.w)) + ((a2.x + a2.y) + (a2.z + a2.w)) + ((a3.x + a3.y) + (a3.z + a3.w));
      int ti = i0 + ck * 16 + ost; int t = d ? (T - 1 - ti) : ti;
      outp[(size_t)(r0 + t) * 256 + h * 64 + rowbase + wid * 4 + orr] = o;
    }
    if (ck + 1 < nck) sstore(b ^ 1);
    __syncthreads();
  }
  const float4 Sf = make_float4(S01.x, S01.y, S23.x, S23.y);
  if (s < 16) *(float4*)(OUTP + O_RWKV + ((((size_t)s * 4 + l) * 2 + d) * 4 + h) * 4096 + row * 64 + e * 4) = Sf;
  else if (c + 1 < nch) {
    const int combo = ((s - 16) * 2 + d) * 4 + h;
    *(float4*)((GF)(p.ws + W_RWE) + (((size_t)combo * 4 + c) * 128 + (isP ? 64 : 0) + row) * 64 + e * 4) = Sf;
  }
}

DEV void rwkv_fix_item(const P& p, int l, int item, char* smem) {
  float* Sc = (float*)smem;
  float* Sn = Sc + 4160;
  float* us = Sn + 4160;
  const int combo = item / 24, rem = item % 24, c = 1 + rem / 8, sub = rem & 7;
  const int b = combo >> 3, d = (combo >> 2) & 1, h = combo & 3;
  GCF E = (GCF)(p.ws + W_RWE) + (size_t)combo * 4 * 8192;
  const int tid = tid_();
  __syncthreads();
  for (int i = tid; i < 4096; i += 256) Sc[(i >> 6) * 65 + (i & 63)] = E[i];
  __syncthreads();
  for (int cc = 1; cc < c; ++cc) {
    auto Es = E + (size_t)cc * 8192; auto Epg = Es + 4096;
    const int r = tid >> 2, jq = (tid & 3) * 16;
    float acc[16];
    {
      float4 pl0 = *(const float4*)(Epg + tid * 4), pl1 = *(const float4*)(Epg + 1024 + tid * 4), pl2 = *(const float4*)(Epg + 2048 + tid * 4), pl3 = *(const float4*)(Epg + 3072 + tid * 4);
#pragma unroll
      for (int j = 0; j < 16; ++j) acc[j] = Es[r * 64 + jq + j];
      *(float4*)(us + tid * 4) = pl0; *(float4*)(us + 1024 + tid * 4) = pl1; *(float4*)(us + 2048 + tid * 4) = pl2; *(float4*)(us + 3072 + tid * 4) = pl3;
    }
    __syncthreads();
    const float* Ep = us;
#pragma unroll 4
    for (int k = 0; k < 64; ++k) {
      const float sv = Sc[r * 65 + k];
      const float4 p0 = *(const float4*)(Ep + k * 64 + jq), p1 = *(const float4*)(Ep + k * 64 + jq + 4), p2 = *(const float4*)(Ep + k * 64 + jq + 8), p3 = *(const float4*)(Ep + k * 64 + jq + 12);
      acc[0] += sv * p0.x; acc[1] += sv * p0.y; acc[2] += sv * p0.z; acc[3] += sv * p0.w;
      acc[4] += sv * p1.x; acc[5] += sv * p1.y; acc[6] += sv * p1.z; acc[7] += sv * p1.w;
      acc[8] += sv * p2.x; acc[9] += sv * p2.y; acc[10] += sv * p2.z; acc[11] += sv * p2.w;
      acc[12] += sv * p3.x; acc[13] += sv * p3.y; acc[14] += sv * p3.z; acc[15] += sv * p3.w;
    }
#pragma unroll
    for (int j = 0; j < 16; ++j) Sn[r * 65 + jq + j] = acc[j];
    __syncthreads();
    for (int i = tid; i < 4160; i += 256) Sc[i] = Sn[i];
    __syncthreads();
  }
  const int T = 4096, CL = 1024, r0 = MCTX + b * 4096;
  GCF rwu = (GCF)(p.ws + W_RWU) + ((size_t)d * 8192 - MCTX) * 256;
  GF rwo = (GF)(p.ws + W_RWO) + (size_t)d * MT_ROWS * 256;
  const int ibase = c * CL + sub * 128;
  {
    float4 ub[8];
#pragma unroll
    for (int u = 0; u < 8; ++u) {
      int i = tid + 256 * u; int st = i >> 4, q4 = (i & 15) * 4;
      int ti = ibase + st; int t = d ? (T - 1 - ti) : ti;
      ub[u] = *(const float4*)(rwu + (size_t)(r0 + t) * 256 + h * 64 + q4);
    }
#pragma unroll
    for (int u = 0; u < 8; ++u) { int i = tid + 256 * u; *(float4*)(us + (i >> 4) * 64 + (i & 15) * 4) = ub[u]; }
  }
  __syncthreads();
  const int row = tid & 63, sg = tid >> 6;
  float srow[64];
#pragma unroll
  for (int k = 0; k < 64; ++k) srow[k] = Sc[row * 65 + k];
  for (int st = sg * 32; st < sg * 32 + 32; ++st) {
    const float* up = us + st * 64;
    float a = 0.f;
#pragma unroll
    for (int k4 = 0; k4 < 16; ++k4) { float4 u = *(const float4*)(up + k4 * 4); a += srow[k4 * 4] * u.x + srow[k4 * 4 + 1] * u.y + srow[k4 * 4 + 2] * u.z + srow[k4 * 4 + 3] * u.w; }
    int ti = ibase + st; int t = d ? (T - 1 - ti) : ti;
    auto o = rwo + (size_t)(r0 + t) * 256 + h * 64 + row;
    *o += a;
  }
}

DEV void attn_item(const P& p, int item, char* smem) {
  GCU qb = (GCU)(p.ws + W_QB); GCU kb = (GCU)(p.ws + W_KB); GCU vt = (GCU)(p.ws + W_VT);
  GU mix = (GU)(p.ws + W_MIX);
  constexpr int KS = 104, VS = 72;
  constexpr int STG = 64 * KS + 64 * VS;
  u16* lds = (u16*)smem;
  const int tid = tid_(), lane = tid & 63, wid = tid >> 6, fr = lane & 15, fq = lane >> 4;
  int h, qrow0, nkt, kbase, cbase;
  if (item < 256) { int b = item >> 7, rem = item & 127; h = rem >> 5; qrow0 = MCTX + b * 4096 + (rem & 31) * 128; nkt = 72; kbase = MCTX + b * 4096; cbase = MT_ROWS + b * 512; }
  else { int it = item - 256, s = it >> 3, rem = it & 7; h = rem >> 1; qrow0 = s * 256 + (rem & 1) * 128; nkt = 4; kbase = s * 256; cbase = 0; }
  bf16x8 Qf[2][3];
#pragma unroll
  for (int qg = 0; qg < 2; ++qg)
#pragma unroll
    for (int ks = 0; ks < 3; ++ks) Qf[qg][ks] = *(const bf16x8*)(qb + (size_t)(qrow0 + wid * 32 + qg * 16 + fr) * 384 + h * 96 + ks * 32 + fq * 8);
  f32x4 O[2][4];
#pragma unroll
  for (int qg = 0; qg < 2; ++qg)
#pragma unroll
    for (int dv = 0; dv < 4; ++dv) O[qg][dv] = (f32x4){0.f, 0.f, 0.f, 0.f};
  float mrun[2] = {-1e30f, -1e30f}, lrun[2] = {0.f, 0.f};
  uint4 gk0, gk1, gk2, gv0, gv1;
  const int kr0 = tid / 12, kc0 = tid % 12, kr1 = (tid + 256) / 12, kc1 = (tid + 256) % 12, kr2 = (tid + 512) / 12, kc2 = (tid + 512) % 12;
  const int vr0 = tid >> 3, vc0 = tid & 7, vr1 = vr0 + 32;
#define A_GLOAD(kt_) do { const int krow0_ = (kt_) < 64 ? kbase + (kt_) * 64 : cbase + ((kt_) - 64) * 64; \
    gk0 = *(const uint4*)(kb + ((size_t)(krow0_ + kr0) * 4 + h) * 96 + kc0 * 8); \
    gk1 = *(const uint4*)(kb + ((size_t)(krow0_ + kr1) * 4 + h) * 96 + kc1 * 8); \
    gk2 = *(const uint4*)(kb + ((size_t)(krow0_ + kr2) * 4 + h) * 96 + kc2 * 8); \
    gv0 = *(const uint4*)(vt + (size_t)(h * 64 + vr0) * MKV + krow0_ + vc0 * 8); \
    gv1 = *(const uint4*)(vt + (size_t)(h * 64 + vr1) * MKV + krow0_ + vc0 * 8); } while (0)
#define A_SSTORE(b_) do { u16* kd_ = lds + (b_) * STG; u16* vd_ = kd_ + 64 * KS; \
    *(uint4*)(kd_ + kr0 * KS + kc0 * 8) = gk0; *(uint4*)(kd_ + kr1 * KS + kc1 * 8) = gk1; *(uint4*)(kd_ + kr2 * KS + kc2 * 8) = gk2; \
    { const int sub_ = vc0 >> 2, G0_ = (vc0 & 3) * 2, G1_ = G0_ + 1; \
      *(uint2*)(vd_ + vr0 * VS + sub_ * 32 + (G0_ & 3) * 8 + (G0_ >> 2) * 4) = make_uint2(gv0.x, gv0.y); \
      *(uint2*)(vd_ + vr0 * VS + sub_ * 32 + (G1_ & 3) * 8 + (G1_ >> 2) * 4) = make_uint2(gv0.z, gv0.w); \
      *(uint2*)(vd_ + vr1 * VS + sub_ * 32 + (G0_ & 3) * 8 + (G0_ >> 2) * 4) = make_uint2(gv1.x, gv1.y); \
      *(uint2*)(vd_ + vr1 * VS + sub_ * 32 + (G1_ & 3) * 8 + (G1_ >> 2) * 4) = make_uint2(gv1.z, gv1.w); } } while (0)
  __syncthreads();
  A_GLOAD(0);
  A_SSTORE(0);
  __syncthreads();
  for (int kt = 0; kt < nkt; ++kt) {
    const int bsel = kt & 1;
    if (kt + 1 < nkt) A_GLOAD(kt + 1);
    const u16* kl = lds + bsel * STG;
    const u16* vl = kl + 64 * KS;
#pragma unroll
    for (int st = 0; st < 2; ++st) {
      bf16x8 Kf[2][3];
#pragma unroll
      for (int sub = 0; sub < 2; ++sub)
#pragma unroll
        for (int ks = 0; ks < 3; ++ks) Kf[sub][ks] = *(const bf16x8*)(kl + (st * 32 + sub * 16 + fr) * KS + ks * 32 + fq * 8);
      bf16x8 Vf[4];
#pragma unroll
      for (int dv = 0; dv < 4; ++dv) Vf[dv] = *(const bf16x8*)(vl + (dv * 16 + fr) * VS + st * 32 + fq * 8);
#pragma unroll
      for (int qg = 0; qg < 2; ++qg) {
        f32x4 sc[2];
#pragma unroll
        for (int sub = 0; sub < 2; ++sub) {
          sc[sub] = (f32x4){0.f, 0.f, 0.f, 0.f};
#pragma unroll
          for (int ks = 0; ks < 3; ++ks) sc[sub] = __builtin_amdgcn_mfma_f32_16x16x32_bf16(Kf[sub][ks], Qf[qg][ks], sc[sub], 0, 0, 0);
        }
        float mx = fmaxf(fmaxf(fmaxf(sc[0][0], sc[0][1]), fmaxf(sc[0][2], sc[0][3])), fmaxf(fmaxf(sc[1][0], sc[1][1]), fmaxf(sc[1][2], sc[1][3])));
        mx = xrow_max(mx);
        const float mn = fmaxf(mrun[qg], mx);
        const float alpha = __builtin_amdgcn_exp2f(mrun[qg] - mn);
        mrun[qg] = mn;
        float pv[8], ps = 0.f;
#pragma unroll
        for (int sub = 0; sub < 2; ++sub)
#pragma unroll
          for (int j = 0; j < 4; ++j) { pv[sub * 4 + j] = __builtin_amdgcn_exp2f(sc[sub][j] - mn); ps += pv[sub * 4 + j]; }
        lrun[qg] = lrun[qg] * alpha + ps;
        uint4 pw = make_uint4(pack2(pv[0], pv[1]), pack2(pv[2], pv[3]), pack2(pv[4], pv[5]), pack2(pv[6], pv[7]));
        bf16x8 pb = __builtin_bit_cast(bf16x8, pw);
        if (__builtin_amdgcn_ballot_w64(alpha < 1.f)) {
#pragma unroll
          for (int dv = 0; dv < 4; ++dv) { O[qg][dv][0] *= alpha; O[qg][dv][1] *= alpha; O[qg][dv][2] *= alpha; O[qg][dv][3] *= alpha; }
        }
#pragma unroll
        for (int dv = 0; dv < 4; ++dv) O[qg][dv] = __builtin_amdgcn_mfma_f32_16x16x32_bf16(Vf[dv], pb, O[qg][dv], 0, 0, 0);
      }
    }
    if (kt + 1 < nkt) A_SSTORE(bsel ^ 1);
    __syncthreads();
  }
#undef A_GLOAD
#undef A_SSTORE
#pragma unroll
  for (int qg = 0; qg < 2; ++qg) {
    const float inv = 1.f / xrow_sum(lrun[qg]);
    const size_t row = (size_t)(qrow0 + wid * 32 + qg * 16 + fr);
#pragma unroll
    for (int dv = 0; dv < 4; ++dv) {
      uint2 w; w.x = pack2(O[qg][dv][0] * inv, O[qg][dv][1] * inv); w.y = pack2(O[qg][dv][2] * inv, O[qg][dv][3] * inv);
      *(uint2*)(mix + row * LDH + 256 + h * 64 + dv * 16 + fq * 4) = w;
    }
  }
}

DEV void post_item(const P& p, int l, int item) {
  GCF proj = (GCF)(p.ws + W_BIG);
  GCF rwa = (GCF)(p.ws + W_RWA); GCF rwo = (GCF)(p.ws + W_RWO);
  GCF rwg = (GCF)(p.ws + W_RWG); GCF hgo = (GCF)(p.ws + W_HGO);
  GU mix = (GU)(p.ws + W_MIX);
  const int j = tid_();
  const float ka = IN(I_RKA)[l * 256 + j], rk = IN(I_RRK)[l * 256 + j], gng = IN(I_RGNG)[l * 256 + j], gnb = IN(I_RGNB)[l * 256 + j];
  const float hgg = IN(I_HGN)[l * 256 + j];
#pragma unroll 1
  for (int tb = 0; tb < 4; ++tb) {
    float r[4], k[4], v[4], a0[4], a1[4], o0[4], o1[4], g[4], h0[4], h1[4], xg[4];
#pragma unroll
    for (int i = 0; i < 4; ++i) {
      const size_t m = (size_t)item * 16 + tb * 4 + i;
      auto pr = proj + m * PLD;
      r[i] = pr[C_AR + j]; k[i] = pr[C_AK + j]; v[i] = pr[C_AV + j]; xg[i] = pr[C_DG + j];
      a0[i] = rwa[m * 256 + j]; a1[i] = rwa[((size_t)MT_ROWS + m) * 256 + j];
      o0[i] = rwo[m * 256 + j]; o1[i] = rwo[((size_t)MT_ROWS + m) * 256 + j];
      g[i] = rwg[m * 256 + j]; h0[i] = hgo[m * 256 + j]; h1[i] = hgo[((size_t)MT_ROWS + m) * 256 + j];
    }
#pragma unroll
    for (int i = 0; i < 4; ++i) {
      const size_t m = (size_t)item * 16 + tb * 4 + i;
      float kd0 = k[i] * (1.f + (a0[i] - 1.f) * ka), kd1 = k[i] * (1.f + (a1[i] - 1.f) * ka);
      float bsum = wave_sum(r[i] * (kd0 + kd1) * rk);
      float of = o0[i] + o1[i];
      float mu = wave_sum(of) * (1.f / 64.f);
      float dv = of - mu;
      float var = wave_sum(dv * dv) * (1.f / 64.f);
      float gn = dv * rsqrtf(var + 64e-5f) * gng + gnb;
      float y = (gn + bsum * v[i]) * g[i];
      mix[m * LDH + j] = f2bf(y);
      float o = h0[i] + h1[i];
      float rs = rsqrtf(wave_sum(o * o) * (1.f / 64.f) + 1e-6f);
      mix[m * LDH + 768 + j] = f2bf(o * rs * hgg * siluf_(xg[i]));
    }
  }
}

constexpr int NPH = 2 + 4 * 12;
__global__ void __launch_bounds__(256, 2) fwd_kernel(P p0, int ph0, int ph1) {
  P p = p0;
  __shared__ __attribute__((aligned(16))) char smem[73728];
  __shared__ uint4 xbw;
  __shared__ int s_item;
  cg::grid_group grid = cg::this_grid();
  if (p.never) grid.sync();
  unsigned* bar = (unsigned*)(p0.ws + W_BAR);
  unsigned* ctr = (unsigned*)(p0.ws + W_CTR);
  const bool multi = (ph1 - ph0) > 1;
  XcdBarrier xb; xb.bar = bar; xb.x = 0; xb.st = (volatile unsigned*)&xbw;
  if (multi) {
    if (tid_() == 0) xbw = make_uint4(0u, 0u, 0u, 0u);
    __syncthreads();
    xb.x = xb_xcc_id();
    if (tid_() == 0) (void)xb_add(&bar[XB_XCNT(xb.x)], 1u);
  }
  for (int ph = ph0; ph < ph1; ++ph) {
    { char* w_ = p0.ws; float* o_ = p0.out; asm volatile("" : "+s"(w_), "+s"(o_)); p.ws = w_; p.out = o_; }
    GCU hbuf = (GCU)(p.ws + W_H);
    GCU actb = (GCU)(p.ws + W_BIG);
    if (ph == 0) phase_setup0(p, smem);
    else if (ph == 1) phase_setup1(p);
    else {
      const int l = (ph - 2) / 12, q = (ph - 2) % 12;
      unsigned* pc = ctr + ph * 64;
      if (q == 0 || q == 9) {
        const int jf = q == 0 ? 0 : 1;
        gemm_phase<EPI_ACT>(p, hbuf, LDH, (GCU)(p.ws + W_WFI) + (size_t)(l * 2 + jf) * 5632 * LDH, LDH, 1024, 96, 44, EpiArg{l, 0, 0.f}, smem);
      } else if (q == 1 || q == 10) {
        const int jf = q == 1 ? 0 : 1;
        gemm_res_phase(p, actb, LDF, (GCU)(p.ws + W_WFO) + (size_t)(l * 2 + jf) * 1024 * LDF, LDF, DFF, EpiArg{l, jf == 0 ? 2 : 8, 0.5f}, smem);
      } else if (q == 2) phase_ln(p, l, 0, l, 3, false);
      else if (q == 8) phase_ln(p, l, 1, l, 6, false);
      else if (q == 11) phase_ln(p, l, 2, l < 3 ? l + 1 : l, 0, l == 3);
      else if (q == 3) {
        gemm_phase<EPI_PROJ>(p, hbuf, LDH, (GCU)(p.ws + W_WIN) + (size_t)l * PLD * LDH, LDH, 1024, 96, 27, EpiArg{l, 0, 0.f}, smem);
      } else if (q == 4) {
        for (;;) {
          int it = next_item(pc, &s_item);
          if (it >= 3472) break;
          if (it < 384) rg_prep_item(p, l, it, smem);
          else if (it < 768) { int t = it - 384; gemm_tile<EPI_LW>(p, (GCU)(p.ws + W_LIN), 384, (GCU)(p.ws + W_LW) + (size_t)l * 512 * 128, 128, 128, (t >> 2) * 128, (t & 3) * 128, EpiArg{l, 0, 0.f}, smem); }
          else if (it < 1152) { int t = it - 768; gemm_tile<EPI_LA>(p, (GCU)(p.ws + W_LIN) + 128, 384, (GCU)(p.ws + W_LA) + (size_t)l * 512 * 128, 128, 128, (t >> 2) * 128, (t & 3) * 128, EpiArg{l, 0, 0.f}, smem); }
          else if (it < 1344) { int t = it - 1152; gemm_tile<EPI_LG>(p, (GCU)(p.ws + W_LIN) + 256, 384, (GCU)(p.ws + W_LG) + (size_t)l * 256 * 128, 128, 128, (t >> 1) * 128, (t & 1) * 128, EpiArg{l, 0, 0.f}, smem); }
          else if (it < 1728) rwkv_prep_item(p, l, it - 1344, smem);
          else if (it < 1936) mla_prep_item(p, l, it - 1728);
          else hgrn_a_item(p, l, it - 1936, smem);
        }
      } else if (q == 5) {
        for (;;) {
          int it = next_item(pc, &s_item);
          if (it >= 4736) break;
          if (it < 288) { gemm_tile<EPI_Q>(p, (GCU)(p.ws + W_CQN), 256, (GCU)(p.ws + W_WUQ) + (size_t)l * 384 * 256, 256, 256, (it / 3) * 128, (it % 3) * 128, EpiArg{l, 0, 0.f}, smem); item_publish(pc + 16); }
          else if (it < 704) { int t = it - 288; gemm_tile<EPI_KV>(p, (GCU)(p.ws + W_CKVN), 128, (GCU)(p.ws + W_WUKV) + (size_t)l * 512 * 128, 128, 128, (t >> 2) * 128, (t & 3) * 128, EpiArg{l, 0, 0.f}, smem); item_publish(pc + 16); }
          else if (it < 1152) {
            int t = it - 704, combo = t / 28, r = t % 28;
            int c = r < 4 ? 0 : 1 + (r - 4) / 8, g = r < 4 ? r : (r - 4) & 7;
            rwkv_scan_item(p, l, 16 + (combo >> 3), (combo >> 2) & 1, combo & 3, c, 4, g, smem);
            item_publish(pc + 40 + combo);
          }
          else if (it < 1536) { hgrn_b_item(p, l, it - 1152); item_publish(pc + 32); }
          else if (it < 1792) { item_wait(pc + 16, 704u); attn_item(p, it - 1536, smem); }
          else if (it < 2176) rg_scan_item(p, l, it - 1792, smem);
          else if (it < 2688) { int t = it - 2176; rwkv_scan_item(p, l, t >> 5, (t >> 4) & 1, (t >> 2) & 3, 0, 1, t & 3, smem); }
          else if (it < 3072) { int t = it - 2688; item_wait(pc + 40 + t / 24, 28u); rwkv_fix_item(p, l, t, smem); }
          else if (it < 3200) { item_wait(pc + 16, 704u); attn_item(p, it - 3072 + 256, smem); }
          else { item_wait(pc + 32, 384u); hgrn_c_item(p, l, it - 3200, smem); }
        }
      } else if (q == 6) {
        for (;;) {
          int it = next_item(pc, &s_item);
          if (it >= 768) break;
          post_item(p, l, it);
        }
      } else if (q == 7) {
        gemm_res_phase(p, (GCU)(p.ws + W_MIX), LDH, (GCU)(p.ws + W_WOUT) + (size_t)l * 1024 * LDH, LDH, 1024, EpiArg{l, 5, 1.0f}, smem);
      }
    }
    if (multi && ph + 1 < ph1) xcd_barrier(xb);
  }
}

#ifndef SINGLE_LAUNCH
#define SINGLE_LAUNCH 1
#endif

extern "C" void kernel_launch(void* const* d_in, const int* in_sizes, int n_in, void* d_out, int out_size, void* d_ws, size_t ws_size,
                              hipStream_t stream) {
  if (ws_size < W_END || n_in < 40) { fprintf(stderr, "workspace too small: %zu < %zu\n", ws_size, (size_t)W_END); return; }
  static int grid_blocks = 0;
  if (!grid_blocks) {
    int dev = 0, cus = 0, per_cu = 0;
    hipGetDevice(&dev);
    hipDeviceGetAttribute(&cus, hipDeviceAttributeMultiprocessorCount, dev);
    hipOccupancyMaxActiveBlocksPerMultiprocessor(&per_cu, fwd_kernel, 256, 0);
    if (per_cu > 2) per_cu = 2;
    if (per_cu < 1) per_cu = 1;
    grid_blocks = cus * per_cu;
  }
  P p{};
  for (int i = 0; i < 40; ++i) p.in[i] = (const float*)d_in[i];
  p.out = (float*)d_out; p.ws = (char*)d_ws; p.never = 0; p.pad = 0;
  hipMemsetAsync(d_ws, 0, 32768, stream);
#if SINGLE_LAUNCH
  int ph0 = 0, ph1 = NPH;
  void* args[] = {&p, &ph0, &ph1};
  hipError_t e = hipLaunchCooperativeKernel((void*)fwd_kernel, dim3(grid_blocks), dim3(256), args, 0, stream);
  if (e != hipSuccess) fprintf(stderr, "cooperative launch failed: %s (grid %d)\n", hipGetErrorString(e), grid_blocks);
#else
  for (int ph = 0; ph < NPH; ++ph) fwd_kernel<<<grid_blocks, 256, 0, stream>>>(p, ph, ph + 1);
#endif
}
```

```cpp
#include <hip/hip_runtime.h>
#include <hip/hip_bf16.h>
#include <hip/hip_cooperative_groups.h>
#include <cstdio>
#include <cstdint>
namespace cg = cooperative_groups;

#define DEV __device__ __forceinline__
typedef unsigned short u16;
#define AS1 __attribute__((address_space(1)))
typedef AS1 float* GF; typedef const AS1 float* GCF; typedef AS1 u16* GU; typedef const AS1 u16* GCU;
typedef const AS1 float4* GCF4; typedef AS1 float4* GF4; typedef const AS1 float2* GCF2; typedef AS1 float2* GF2;
typedef const AS1 uint4* GCU4; typedef AS1 uint4* GU4; typedef const AS1 uint2* GCU2; typedef AS1 uint2* GU2; typedef AS1 unsigned* GUI;
typedef float f4v_ __attribute__((ext_vector_type(4)));
__device__ __forceinline__ float4 ldg4(GCF q) { f4v_ v = *(const AS1 f4v_*)q; return make_float4(v.x, v.y, v.z, v.w); }
#define IN(i) ((GCF)p.in[i])
#define OUTP ((GF)p.out)
typedef __attribute__((ext_vector_type(8))) short bf16x8;
typedef __attribute__((ext_vector_type(4))) float f32x4;
typedef float f2_ __attribute__((ext_vector_type(2)));

constexpr int LDH = 1088, LDF = 2880;
constexpr int DM = 1024, MT_ROWS = 12288, MCTX = 4096, MKV = 13312, DFF = 2816, DIN = 3360, PLD = 3456;
constexpr float ALPHA = 1.6817928305074292f;
constexpr float QSCALE = 0.10206207261596575f * 1.4426950408889634f;
constexpr int C_AR = 0, C_AK = 256, C_AV = 512, C_AW = 768, C_AA = 896, C_AG = 1024, C_BQ = 1152, C_BKV = 1408, C_BPE = 1536,
              C_CX = 1568, C_CG = 1824, C_DQ = 2080, C_DF = 2336, C_DI = 2848, C_DG = 3104;
enum { I_XP = 0, I_XS, I_CCKV, I_CKPE, I_SRWKV, I_SRG, I_SHG, I_C, I_CCTX, I_WADA, I_BADA, I_LNG, I_LNB, I_WFI, I_WFO, I_WIN, I_WOUT,
       I_RW0, I_RW2, I_RA0, I_RA2, I_RG2, I_RKK, I_RKA, I_RRK, I_RGNG, I_RGNB, I_QNG, I_WUQ, I_KVNG, I_WUKV,
       I_CVW, I_CVB, I_GWA, I_GBA, I_GWX, I_GBX, I_GLAM, I_HLB, I_HGN };
constexpr size_t O_Y = 0, O_CKV = 12582912, O_KPE = 14680064, O_RWKV = 15204352, O_RGLRU = 17301504, O_HGRN = 17334272;

constexpr size_t al256(size_t x) { return (x + 255) & ~(size_t)255; }
constexpr size_t W_BAR = 0;
constexpr size_t W_CTR = 16384;
constexpr size_t W_WFI = 32768;
constexpr size_t W_WFO = W_WFI + (size_t)4 * 2 * 5632 * LDH * 2;
constexpr size_t W_WIN = W_WFO + (size_t)4 * 2 * 1024 * LDF * 2;
constexpr size_t W_WOUT = W_WIN + (size_t)4 * 3456 * LDH * 2;
constexpr size_t W_WUQ = W_WOUT + (size_t)4 * 1024 * LDH * 2;
constexpr size_t W_WUKV = W_WUQ + (size_t)4 * 384 * 256 * 2;
constexpr size_t W_MODS = W_WUKV + (size_t)4 * 512 * 128 * 2;
constexpr size_t W_LBS = W_MODS + (size_t)4 * 3 * 9216 * 4;
constexpr size_t W_X = W_LBS + 8192;
constexpr size_t W_H = W_X + (size_t)MT_ROWS * 1024 * 4;
constexpr size_t W_BIG = W_H + (size_t)MT_ROWS * LDH * 2;
constexpr size_t W_MIX = W_BIG + (size_t)MT_ROWS * PLD * 4;
constexpr size_t SZ_T = (size_t)MT_ROWS * 256 * 4;
constexpr size_t W_RWW = W_MIX + (size_t)MT_ROWS * LDH * 2;
constexpr size_t W_RWA = W_RWW + 2 * SZ_T;
constexpr size_t W_RWKK = W_RWA + 2 * SZ_T;
constexpr size_t W_RWG = W_RWKK + SZ_T;
constexpr size_t W_RWO = W_RWG + SZ_T;
constexpr size_t W_RGA = W_RWO + 2 * SZ_T;
constexpr size_t W_RGB = W_RGA + 2 * SZ_T;
constexpr size_t W_RGTA = W_RGB + 2 * SZ_T;
constexpr size_t W_RGTB = W_RGTA + (size_t)2 * 384 * 256 * 4;
constexpr size_t W_HGO = W_RGTB + (size_t)2 * 384 * 256 * 4;
constexpr size_t W_HGS = W_HGO + 2 * SZ_T;
constexpr size_t W_HGD = W_HGS + (size_t)1536 * 4096 * 4;
constexpr size_t W_CQN = W_HGD + (size_t)1536 * 64 * 4;
constexpr size_t W_CKVN = W_CQN + (size_t)MT_ROWS * 256 * 2;
constexpr size_t W_QB = W_CKVN + (size_t)MKV * 128 * 2;
constexpr size_t W_KB = W_QB + (size_t)MT_ROWS * 384 * 2;
constexpr size_t W_VT = W_KB + (size_t)MKV * 384 * 2;
constexpr size_t W_HGS2 = W_HGS;
constexpr size_t W_RWU = W_VT + (size_t)4 * 64 * MKV * 2;
constexpr size_t W_RWE = W_RWU + (size_t)2 * 8192 * 256 * 4;
constexpr size_t W_ROPE = W_RWE + (size_t)16 * 4 * 128 * 64 * 4;
constexpr size_t W_LW = W_ROPE + (size_t)4096 * 32 * 8;
constexpr size_t W_LA = W_LW + (size_t)4 * 512 * 128 * 2;
constexpr size_t W_LG = W_LA + (size_t)4 * 512 * 128 * 2;
constexpr size_t W_END = W_LG + (size_t)4 * 256 * 128 * 2;
constexpr size_t W_XD = W_BIG + (size_t)80 * 1024 * 1024;
constexpr size_t W_LIN = W_MIX;

struct P {
  const float* in[40];
  float* out;
  char* ws;
  int never;
  int pad;
};

DEV int tid_() { int t = __builtin_amdgcn_workitem_id_x(); asm volatile("" : "+v"(t)); return t; }
DEV unsigned pack2(float a, float b) { unsigned r; asm("v_cvt_pk_bf16_f32 %0, %1, %2" : "=v"(r) : "v"(a), "v"(b)); return r; }
DEV u16 f2bf(float f) { return (u16)(pack2(f, f) & 0xffffu); }
DEV float bf2f(u16 b) { return __uint_as_float(((unsigned)b) << 16); }
DEV float sigmoidf_(float x) { return 1.f / (1.f + __expf(-x)); }
DEV float siluf_(float x) { return x / (1.f + __expf(-x)); }
DEV float softplusf_(float x) { return fmaxf(x, 0.f) + __logf(1.f + __expf(-fabsf(x))); }
DEV float tanhf_(float x) { float e = __expf(2.f * x); return 1.f - 2.f / (e + 1.f); }
template <int CTRL> DEV float dppf(float x) {
  return __builtin_bit_cast(float, __builtin_amdgcn_update_dpp(0, __builtin_bit_cast(int, x), CTRL, 0xf, 0xf, false));
}
DEV float row16_sum(float x) {
  x += dppf<0x121>(x); x += dppf<0x122>(x); x += dppf<0x124>(x); x += dppf<0x128>(x);
  return x;
}
DEV float xrow_max(float x) {
  auto s = __builtin_amdgcn_permlane16_swap(__float_as_uint(x), __float_as_uint(x), false, false);
  x = fmaxf(__uint_as_float(s[0]), __uint_as_float(s[1]));
  auto t = __builtin_amdgcn_permlane32_swap(__float_as_uint(x), __float_as_uint(x), false, false);
  return fmaxf(__uint_as_float(t[0]), __uint_as_float(t[1]));
}
DEV float xrow_sum(float x) {
  auto s = __builtin_amdgcn_permlane16_swap(__float_as_uint(x), __float_as_uint(x), false, false);
  x = __uint_as_float(s[0]) + __uint_as_float(s[1]);
  auto t = __builtin_amdgcn_permlane32_swap(__float_as_uint(x), __float_as_uint(x), false, false);
  return __uint_as_float(t[0]) + __uint_as_float(t[1]);
}
DEV float wave_sum(float v) { return xrow_sum(row16_sum(v)); }
DEV int cond_idx(int m) { return m < MCTX ? 0 : 1 + ((m - MCTX) >> 12); }
DEV int seq_row0(int s) { return s < 16 ? s * 256 : MCTX + (s - 16) * 4096; }
DEV int seq_len(int s) { return s < 16 ? 256 : 4096; }

#define XB_TMO      128
#define XB_XCNT(j)  (256  + 64 * (j))
#define XB_XSUB(j)  (1280 + 64 * (j))
#define XB_XGEN(j)  (2304 + 64 * (j))
#define XB_TOP      3328
#define XB_TOPGEN   3392
#define XB_SPIN_CAP (1u << 22)
DEV unsigned xb_ld(unsigned* p) { return __hip_atomic_load(p, __ATOMIC_RELAXED, __HIP_MEMORY_SCOPE_AGENT); }
DEV unsigned xb_add(unsigned* p, unsigned v) { return __hip_atomic_fetch_add(p, v, __ATOMIC_RELAXED, __HIP_MEMORY_SCOPE_AGENT); }
DEV unsigned xb_xcc_id() { return (unsigned)__builtin_amdgcn_s_getreg((3 << 11) | 20) & 0xFu; }
#define XB_SPIN(cond, bar) do { unsigned _sp = 0; while (cond) { __builtin_amdgcn_s_sleep(1); \
    if ((++_sp & 255u) == 0u) { if (xb_ld(&(bar)[XB_TMO])) break; if (_sp > XB_SPIN_CAP) { atomicAdd(&(bar)[XB_TMO], 1u); break; } } } } while (0)

struct XcdBarrier { unsigned* bar; unsigned x; volatile unsigned* st; };

DEV void xcd_barrier_complete(unsigned* bar, unsigned x, unsigned& nloc, unsigned& nx) {
  const unsigned G = gridDim.x;
  unsigned sum, cnt, mine, sp = 0u;
  for (;;) {
    sum = 0u; cnt = 0u; mine = 0u;
#pragma unroll
    for (unsigned j = 0; j < 16; ++j) { const unsigned c = xb_ld(&bar[XB_XCNT(j)]); sum += c; cnt += (c > 0u) ? 1u : 0u; mine = (j == x) ? c : mine; }
    if (sum == G) break;
    __builtin_amdgcn_s_sleep(1);
    if ((++sp & 255u) == 0u) { if (xb_ld(&bar[XB_TMO])) break; if (sp > XB_SPIN_CAP) { atomicAdd(&bar[XB_TMO], 1u); break; } }
  }
  nloc = mine > 0u ? mine : 1u; nx = cnt > 0u ? cnt : 1u;
}
DEV void xcd_barrier(const XcdBarrier& b) {
  asm volatile("s_waitcnt vmcnt(0)" ::: "memory");
  __syncthreads();
  if (tid_() == 0) {
    unsigned* bar = b.bar;
    __builtin_amdgcn_s_waitcnt(0);
    unsigned nloc = b.st[0], nx = b.st[1];
    if (nloc == 0u) { xcd_barrier_complete(bar, b.x, nloc, nx); b.st[0] = nloc; b.st[1] = nx; }
    const unsigned old = xb_add(&bar[XB_XSUB(b.x)], 1u);
    const unsigned gen = old / nloc;
    if (old + 1u == (gen + 1u) * nloc) {
      __builtin_amdgcn_fence(__ATOMIC_RELEASE, "agent");
      asm volatile("s_waitcnt vmcnt(0)" ::: "memory");
      const unsigned og = xb_add(&bar[XB_TOP], 1u);
      const unsigned tg = og / nx;
      if (og + 1u == (tg + 1u) * nx) xb_add(&bar[XB_TOPGEN], 1u);
      else XB_SPIN(xb_ld(&bar[XB_TOPGEN]) == tg, bar);
      __builtin_amdgcn_fence(__ATOMIC_ACQUIRE, "agent");
      xb_add(&bar[XB_XGEN(b.x)], 1u);
      asm volatile("s_waitcnt vmcnt(0)" ::: "memory");
    } else {
      XB_SPIN(xb_ld(&bar[XB_XGEN(b.x)]) == gen, bar);
      __builtin_amdgcn_fence(__ATOMIC_ACQUIRE, "agent");
      asm volatile("s_waitcnt vmcnt(0)" ::: "memory");
    }
  }
  __syncthreads();
}
DEV void item_publish(unsigned* ctr) {
  asm volatile("s_waitcnt vmcnt(0)" ::: "memory");
  __syncthreads();
  if (tid_() == 0) {
    __builtin_amdgcn_fence(__ATOMIC_RELEASE, "agent");
    asm volatile("s_waitcnt vmcnt(0)" ::: "memory");
    xb_add(ctr, 1u);
  }
}
DEV void item_wait(unsigned* ctr, unsigned need) {
  if (tid_() == 0) {
    unsigned sp = 0;
    while (xb_ld(ctr) < need) { __builtin_amdgcn_s_sleep(4); if (++sp > (1u << 23)) break; }
    __builtin_amdgcn_fence(__ATOMIC_ACQUIRE, "agent");
    asm volatile("s_waitcnt vmcnt(0)" ::: "memory");
  }
  __syncthreads();
}
DEV int next_item(unsigned* ctr, volatile int* s_item) {
  __syncthreads();
  if (tid_() == 0) *s_item = (int)xb_add(ctr, 1u);
  __syncthreads();
  return *s_item;
}

template <int MAP>
DEV void cvt_tile(GCF src, int N, int k0, int n0, GU dst, int K, char* smem) {
  float* tile = (float*)smem;
  const int tid = tid_();
  float4 v[16];
#pragma unroll
  for (int i = 0; i < 16; ++i) {
    int r = (tid >> 5) + 8 * i, c = (tid & 31) * 4;
    v[i] = make_float4(0.f, 0.f, 0.f, 0.f);
    if (n0 + c < N) v[i] = *(const float4*)(src + (size_t)(k0 + r) * N + n0 + c);
  }
  __syncthreads();
#pragma unroll
  for (int i = 0; i < 16; ++i) {
    int r = (tid >> 5) + 8 * i, c = (tid & 31) * 4;
    tile[r * 129 + c] = v[i].x; tile[r * 129 + c + 1] = v[i].y; tile[r * 129 + c + 2] = v[i].z; tile[r * 129 + c + 3] = v[i].w;
  }
  __syncthreads();
#pragma unroll
  for (int i = 0; i < 8; ++i) {
    int idx = tid + 256 * i, n = idx >> 4, ch = idx & 15;
    unsigned w[4];
#pragma unroll
    for (int j = 0; j < 4; ++j) w[j] = pack2(tile[(ch * 8 + 2 * j) * 129 + n], tile[(ch * 8 + 2 * j + 1) * 129 + n]);
    int nn = n0 + n, drow = nn;
    if (MAP == 1) { int isup = nn >= DFF; int c = nn - isup * DFF; drow = (c >> 6) * 128 + ((c >> 5) & 1) * 64 + isup * 32 + (c & 31); }
    *(uint4*)(dst + (size_t)drow * K + k0 + ch * 8) = make_uint4(w[0], w[1], w[2], w[3]);
  }
}

DEV void mods_tile(const P& p, int item, char* smem) {
  float* sc = (float*)smem;
  float* red = sc + 3 * 1024;
  const int tid = tid_(), l = item / 72, ct = item % 72;
  __syncthreads();
  for (int i = tid; i < 3 * 1024; i += 256) {
    int r = i >> 10, k = i & 1023;
    float c = (r == 0) ? IN(I_CCTX)[k] : IN(I_C)[(r - 1) * 1024 + k];
    sc[i] = siluf_(c);
  }
  __syncthreads();
  const int kq = tid >> 5, c4 = (tid & 31) * 4;
  float acc[3][4];
#pragma unroll
  for (int r = 0; r < 3; ++r)
#pragma unroll
    for (int j = 0; j < 4; ++j) acc[r][j] = 0.f;
  auto w = IN(I_WADA) + ((size_t)l * 1024 + kq * 128) * 9216 + ct * 128 + c4;
#pragma unroll 8
  for (int k = 0; k < 128; ++k) {
    float4 v = *(const float4*)(w + (size_t)k * 9216);
    float s0 = sc[kq * 128 + k], s1 = sc[1024 + kq * 128 + k], s2 = sc[2048 + kq * 128 + k];
    acc[0][0] += s0 * v.x; acc[0][1] += s0 * v.y; acc[0][2] += s0 * v.z; acc[0][3] += s0 * v.w;
    acc[1][0] += s1 * v.x; acc[1][1] += s1 * v.y; acc[1][2] += s1 * v.z; acc[1][3] += s1 * v.w;
    acc[2][0] += s2 * v.x; acc[2][1] += s2 * v.y; acc[2][2] += s2 * v.z; acc[2][3] += s2 * v.w;
  }
#pragma unroll
  for (int r = 0; r < 3; ++r)
#pragma unroll
    for (int j = 0; j < 4; ++j) red[(kq * 3 + r) * 128 + c4 + j] = acc[r][j];
  __syncthreads();
  GF mods = (GF)(p.ws + W_MODS);
  for (int i = tid; i < 3 * 128; i += 256) {
    int r = i >> 7, c = i & 127;
    float s = 0.f;
#pragma unroll
    for (int q = 0; q < 8; ++q) s += red[(q * 3 + r) * 128 + c];
    int col = ct * 128 + c;
    mods[((size_t)l * 3 + r) * 9216 + col] = s + IN(I_BADA)[(size_t)l * 9216 + col];
  }
}

DEV void phase_setup0(const P& p, char* smem) {
  const int n0 = 8 * 352, n1 = 8 * 176, n2 = 4 * 216, n3 = 4 * 64, n4 = 4 * 6, n5 = 4 * 4, n6 = 288, n7 = 1;
  const int n8 = 512, n9 = 2560;
  const int total = n0 + n1 + n2 + n3 + n4 + n5 + n6 + n7 + n8 + n9;
  for (int it = blockIdx.x; it < total; it += gridDim.x) {
    int i = it;
    if (i >= total - n9) {
      int idx = (i - (total - n9)) * 256 + tid_();
      if (idx < 2 * 262144) {
        const int which = idx >> 18, e = idx & 262143, l = e >> 16, n = (e >> 7) & 511, k = e & 127;
        const int d = n >> 8, jc = n & 255;
        float v = 0.f;
        if ((k >> 6) == d) v = IN(which ? I_RA2 : I_RW2)[(((size_t)l * 2 + d) * 64 + (k & 63)) * 256 + jc];
        ((GU)(p.ws + (which ? W_LA : W_LW)))[e] = f2bf(v);
      } else {
        const int e = idx - 2 * 262144, l = e >> 15, n = (e >> 7) & 255, k = e & 127;
        ((GU)(p.ws + W_LG))[e] = f2bf(IN(I_RG2)[((size_t)l * 128 + k) * 256 + n]);
      }
      continue;
    }
    i = it;
    if (i >= total - n9 - n8) i += 0;
    if (i >= total - n9 - n8) {
      int idx = (i - (total - n9 - n8)) * 256 + tid_();
      int t = idx >> 5, ri = idx & 31;
      float pos = (float)((ri < 16) ? (t >> 6) : (t & 63));
      float inv = expf(-(float)(ri & 7) * (9.210340371976184f / 8.f));
      float sn, cs; sincosf(pos * inv, &sn, &cs);
      ((GF)(p.ws + W_ROPE))[idx * 2] = cs; ((GF)(p.ws + W_ROPE))[idx * 2 + 1] = sn;
      continue;
    }
    if (i < n6) { mods_tile(p, i, smem); continue; }
    i -= n6;
    if (i < n0) { int mat = i / 352, t = i % 352; int kt = t / 44, nt = t % 44;
      cvt_tile<1>(IN(I_WFI) + (size_t)mat * 1024 * 5632, 5632, kt * 128, nt * 128, (GU)(p.ws + W_WFI) + (size_t)mat * 5632 * LDH, LDH, smem); continue; }
    i -= n0;
    if (i < n1) { int mat = i / 176, t = i % 176; int kt = t / 8, nt = t % 8;
      cvt_tile<0>(IN(I_WFO) + (size_t)mat * 2816 * 1024, 1024, kt * 128, nt * 128, (GU)(p.ws + W_WFO) + (size_t)mat * 1024 * LDF, LDF, smem); continue; }
    i -= n1;
    if (i < n2) { int mat = i / 216, t = i % 216; int kt = t / 27, nt = t % 27;
      cvt_tile<0>(IN(I_WIN) + (size_t)mat * 1024 * DIN, DIN, kt * 128, nt * 128, (GU)(p.ws + W_WIN) + (size_t)mat * PLD * LDH, LDH, smem); continue; }
    i -= n2;
    if (i < n3) { int mat = i / 64, t = i % 64; int kt = t / 8, nt = t % 8;
      cvt_tile<0>(IN(I_WOUT) + (size_t)mat * 1024 * 1024, 1024, kt * 128, nt * 128, (GU)(p.ws + W_WOUT) + (size_t)mat * 1024 * LDH, LDH, smem); continue; }
    i -= n3;
    if (i < n4) { int mat = i / 6, t = i % 6; int kt = t / 3, nt = t % 3;
      cvt_tile<0>(IN(I_WUQ) + (size_t)mat * 256 * 384, 384, kt * 128, nt * 128, (GU)(p.ws + W_WUQ) + (size_t)mat * 384 * 256, 256, smem); continue; }
    i -= n4;
    if (i < n5) { int mat = i / 4, t = i % 4; int kt = t / 4, nt = t % 4;
      cvt_tile<0>(IN(I_WUKV) + (size_t)mat * 128 * 512, 512, kt * 128, nt * 128, (GU)(p.ws + W_WUKV) + (size_t)mat * 512 * 128, 128, smem); continue; }
    GF lbs = (GF)(p.ws + W_LBS);
    for (int e = tid_(); e < 512; e += 256) {
      float v[4], mx = -1e30f;
#pragma unroll
      for (int l = 0; l < 4; ++l) { v[l] = IN(I_HLB)[l * 512 + e]; mx = fmaxf(mx, v[l]); }
      float s = 0.f;
#pragma unroll
      for (int l = 0; l < 4; ++l) { v[l] = expf(v[l] - mx); s += v[l]; }
      float inv = 1.f / s, cum = 0.f;
#pragma unroll
      for (int l = 0; l < 4; ++l) { cum += v[l] * inv; lbs[l * 512 + e] = cum - v[0] * inv; }
    }
  }
}

DEV void phase_setup1(const P& p) {
  GCF mods = (GCF)(p.ws + W_MODS);
  GF x = (GF)(p.ws + W_X);
  GU h = (GU)(p.ws + W_H);
  const int lane = tid_() & 63, wid = tid_() >> 6;
  for (int m = blockIdx.x * 4 + wid; m < MT_ROWS; m += gridDim.x * 4) {
    auto src = m < MCTX ? IN(I_XP) + (size_t)m * 1024 : IN(I_XS) + (size_t)(m - MCTX) * 1024;
    auto md = mods + (size_t)cond_idx(m) * 9216;
#pragma unroll
    for (int i = 0; i < 4; ++i) {
      int c = lane * 4 + 256 * i;
      float4 v = *(const float4*)(src + c);
      float4 sh = *(const float4*)(md + c), sc = *(const float4*)(md + 1024 + c);
      *(float4*)(x + (size_t)m * 1024 + c) = v;
      uint2 o; o.x = pack2(v.x * (1.f + sc.x) + sh.x, v.y * (1.f + sc.y) + sh.y); o.y = pack2(v.z * (1.f + sc.z) + sh.z, v.w * (1.f + sc.w) + sh.w);
      *(uint2*)(h + (size_t)m * LDH + c) = o;
    }
  }
}

DEV void phase_ln(const P& p, int l, int j, int lm, int mi, bool last) {
  GCF mods = (GCF)(p.ws + W_MODS);
  GF x = (GF)(p.ws + W_X);
  GU h = (GU)(p.ws + W_H);
  auto g = IN(I_LNG) + ((size_t)l * 3 + j) * 1024;
  auto b = IN(I_LNB) + ((size_t)l * 3 + j) * 1024;
  const int lane = tid_() & 63, wid = tid_() >> 6;
  float4 gg4[4], bb4[4];
#pragma unroll
  for (int i = 0; i < 4; ++i) { gg4[i] = *(const float4*)(g + lane * 4 + 256 * i); bb4[i] = *(const float4*)(b + lane * 4 + 256 * i); }
  const int stride = gridDim.x * 4;
  for (int m0r = blockIdx.x * 4 + wid; m0r < MT_ROWS; m0r += 2 * stride) {
    float4 v[2][4], sh4[2][4], sc4[2][4];
#pragma unroll
    for (int rr = 0; rr < 2; ++rr) {
      const int m = m0r + rr * stride;
      if (m < MT_ROWS) {
        auto md = mods + ((size_t)lm * 3 + cond_idx(m)) * 9216 + (size_t)mi * 1024;
#pragma unroll
        for (int i = 0; i < 4; ++i) v[rr][i] = *(const float4*)(x + (size_t)m * 1024 + lane * 4 + 256 * i);
#pragma unroll
        for (int i = 0; i < 4; ++i) { sh4[rr][i] = *(const float4*)(md + lane * 4 + 256 * i); sc4[rr][i] = *(const float4*)(md + 1024 + lane * 4 + 256 * i); }
        if (m >= 8192) {
          GCF xd = (GCF)(p.ws + W_XD) + (size_t)(m - 8192) * 1024;
#pragma unroll
          for (int i = 0; i < 4; ++i) { float4 e = *(const float4*)(xd + lane * 4 + 256 * i); v[rr][i].x += e.x; v[rr][i].y += e.y; v[rr][i].z += e.z; v[rr][i].w += e.w; }
        }
      }
    }
#pragma unroll
    for (int rr = 0; rr < 2; ++rr) {
      const int m = m0r + rr * stride;
      if (m < MT_ROWS) {
        float s = 0.f;
#pragma unroll
        for (int i = 0; i < 4; ++i) s += v[rr][i].x + v[rr][i].y + v[rr][i].z + v[rr][i].w;
        float mu = wave_sum(s) * (1.f / 1024.f);
        float q = 0.f;
#pragma unroll
        for (int i = 0; i < 4; ++i) { float a = v[rr][i].x - mu, bb = v[rr][i].y - mu, c = v[rr][i].z - mu, d = v[rr][i].w - mu; q += a * a + bb * bb + c * c + d * d; }
        float rstd = rsqrtf(wave_sum(q) * (1.f / 1024.f) + 1e-5f);
#pragma unroll
        for (int i = 0; i < 4; ++i) {
          int c = lane * 4 + 256 * i;
          float4 gg = gg4[i], bb = bb4[i];
          float4 o;
          o.x = (v[rr][i].x - mu) * rstd * gg.x + bb.x; o.y = (v[rr][i].y - mu) * rstd * gg.y + bb.y;
          o.z = (v[rr][i].z - mu) * rstd * gg.z + bb.z; o.w = (v[rr][i].w - mu) * rstd * gg.w + bb.w;
          if (last) { *(float4*)(OUTP + O_Y + (size_t)m * 1024 + c) = o; }
          else {
            *(float4*)(x + (size_t)m * 1024 + c) = o;
            float4 sh = sh4[rr][i], sc = sc4[rr][i];
            uint2 w; w.x = pack2(o.x * (1.f + sc.x) + sh.x, o.y * (1.f + sc.y) + sh.y); w.y = pack2(o.z * (1.f + sc.z) + sh.z, o.w * (1.f + sc.w) + sh.w);
            *(uint2*)(h + (size_t)m * LDH + c) = w;
          }
        }
      }
    }
  }
}

enum { EPI_ACT = 0, EPI_RES, EPI_PROJ, EPI_Q, EPI_KV, EPI_LW, EPI_LA, EPI_LG, EPI_RESD };
struct EpiArg { int l; int gidx; float gs; };

template <int EPI>
DEV void gemm_tile(const P& p, GCU A, int lda, GCU Bt, int ldb, int K,
                                       int m0, int n0, EpiArg ea, char* smem) {
  const int tid = tid_(), lane = tid & 63, wid = tid >> 6, wr = wid >> 1, wc = wid & 1, fr = lane & 15, fq = lane >> 4;
  f32x4 acc[4][4];
#pragma unroll
  for (int i = 0; i < 4; ++i)
#pragma unroll
    for (int j = 0; j < 4; ++j) acc[i][j] = (f32x4){0.f, 0.f, 0.f, 0.f};
  const int lrow = tid >> 3, lpos = tid & 7, gch = lpos ^ ((lrow >> 1) & 7);
  GCU Ag = A + (size_t)(m0 + lrow) * lda + gch * 8;
  GCU Bg = Bt + (size_t)(n0 + lrow) * ldb + gch * 8;
  typedef __attribute__((address_space(3))) unsigned* lds_u;
#define G_ISSUE(stage_, koff) do { \
    char* sb_ = smem + (stage_) * 32768 + wid * 1024; \
    _Pragma("unroll") for (int i = 0; i < 4; ++i) { \
      __builtin_amdgcn_global_load_lds((const AS1 unsigned*)(Ag + (size_t)(32 * i) * lda + (koff)), (lds_u)(sb_ + i * 4096), 16, 0, 0); \
      __builtin_amdgcn_global_load_lds((const AS1 unsigned*)(Bg + (size_t)(32 * i) * ldb + (koff)), (lds_u)(sb_ + 16384 + i * 4096), 16, 0, 0); } } while (0)
  const int nk = K >> 6;
  float xpre[EPI == EPI_RES ? 64 : 1], gpre[4];
  if (EPI == EPI_RES) {
    GCF xq = (GCF)(p.ws + W_X) + (size_t)(m0 + wr * 64 + fq * 4) * 1024 + n0 + wc * 64 + fr;
#pragma unroll
    for (int mi = 0; mi < 4; ++mi)
#pragma unroll
      for (int j = 0; j < 4; ++j)
#pragma unroll
        for (int ni = 0; ni < 4; ++ni) xpre[(mi * 4 + j) * 4 + ni] = xq[(size_t)(mi * 16 + j) * 1024 + ni * 16];
    GCF mq = (GCF)(p.ws + W_MODS) + ((size_t)ea.l * 3 + cond_idx(m0)) * 9216 + (size_t)ea.gidx * 1024 + n0 + wc * 64 + fr;
#pragma unroll
    for (int ni = 0; ni < 4; ++ni) gpre[ni] = mq[ni * 16] * ea.gs;
  }
  __syncthreads();
  G_ISSUE(0, 0);
  asm volatile("s_waitcnt vmcnt(0)" ::: "memory");
  __syncthreads();
  const int sw = (fr >> 1) & 7;
  for (int kt = 0; kt < nk; ++kt) {
    const int buf = kt & 1;
    if (kt + 1 < nk) G_ISSUE(buf ^ 1, (kt + 1) * 64);
    const char* as = smem + buf * 32768 + (wr * 64 + fr) * 128;
    const char* bs = smem + buf * 32768 + 16384 + (wc * 64 + fr) * 128;
#pragma unroll
    for (int ks = 0; ks < 2; ++ks) {
      const int co = ((ks * 4 + fq) ^ sw) * 16;
      bf16x8 af[4], bfr[4];
#pragma unroll
      for (int i = 0; i < 4; ++i) { af[i] = *(const bf16x8*)(as + i * 2048 + co); bfr[i] = *(const bf16x8*)(bs + i * 2048 + co); }
      __builtin_amdgcn_s_setprio(1);
#pragma unroll
      for (int i = 0; i < 4; ++i)
#pragma unroll
        for (int j = 0; j < 4; ++j) acc[i][j] = __builtin_amdgcn_mfma_f32_16x16x32_bf16(af[i], bfr[j], acc[i][j], 0, 0, 0);
      __builtin_amdgcn_s_setprio(0);
      __builtin_amdgcn_sched_barrier(0);
    }
    asm volatile("s_waitcnt vmcnt(0)" ::: "memory");
    __syncthreads();
  }
#undef G_ISSUE
  const int rbase = m0 + wr * 64 + fq * 4, cbase = n0 + wc * 64 + fr;
  if (EPI == EPI_ACT) {
    GU act = (GU)(p.ws + W_BIG);
#pragma unroll
    for (int mi = 0; mi < 4; ++mi)
#pragma unroll
      for (int j = 0; j < 4; ++j) {
        int row = rbase + mi * 16 + j;
#pragma unroll
        for (int ni = 0; ni < 2; ++ni) {
          float g = acc[mi][ni][j], u = acc[mi][ni + 2][j];
          act[(size_t)row * LDF + (n0 >> 1) + wc * 32 + ni * 16 + fr] = f2bf(siluf_(g) * u);
        }
        __builtin_amdgcn_sched_barrier(0);
      }
  } else if (EPI == EPI_RES) {
    GF x = (GF)(p.ws + W_X);
#pragma unroll
    for (int mi = 0; mi < 4; ++mi) {
#pragma unroll
      for (int j = 0; j < 4; ++j) {
        auto xr = x + (size_t)(rbase + mi * 16 + j) * 1024 + cbase;
#pragma unroll
        for (int ni = 0; ni < 4; ++ni) xr[ni * 16] = ALPHA * xpre[(mi * 4 + j) * 4 + ni] + gpre[ni] * acc[mi][ni][j];
      }
    }
  } else if (EPI == EPI_RESD) {
    GF xd = (GF)(p.ws + W_XD);
    GCF mods = (GCF)(p.ws + W_MODS);
    auto md = mods + ((size_t)ea.l * 3 + cond_idx(m0)) * 9216 + (size_t)ea.gidx * 1024 + cbase;
    float gate[4];
#pragma unroll
    for (int ni = 0; ni < 4; ++ni) gate[ni] = md[ni * 16] * ea.gs;
#pragma unroll
    for (int mi = 0; mi < 4; ++mi) {
#pragma unroll
      for (int j = 0; j < 4; ++j) {
        auto xr = xd + (size_t)(rbase + mi * 16 + j - 8192) * 1024 + cbase;
#pragma unroll
        for (int ni = 0; ni < 4; ++ni) xr[ni * 16] = gate[ni] * acc[mi][ni][j];
      }
      __builtin_amdgcn_sched_barrier(0);
    }
  } else if (EPI == EPI_PROJ) {
    GF pr = (GF)(p.ws + W_BIG);
#pragma unroll
    for (int mi = 0; mi < 4; ++mi) {
#pragma unroll
      for (int j = 0; j < 4; ++j) {
        auto prr = pr + (size_t)(rbase + mi * 16 + j) * PLD + cbase;
#pragma unroll
        for (int ni = 0; ni < 4; ++ni) prr[ni * 16] = acc[mi][ni][j];
      }
      __builtin_amdgcn_sched_barrier(0);
    }
    if (n0 >= C_AW && n0 < C_AW + 384) {
      GU lin = (GU)(p.ws + W_LIN);
      const int kind = (n0 - C_AW) >> 7;
#pragma unroll
      for (int mi = 0; mi < 4; ++mi)
#pragma unroll
        for (int j = 0; j < 4; ++j)
#pragma unroll
          for (int ni = 0; ni < 4; ++ni) {
            float v = acc[mi][ni][j];
            v = kind == 0 ? tanhf_(v) : (kind == 2 ? sigmoidf_(v) : v);
            lin[(size_t)(rbase + mi * 16 + j) * 384 + (cbase - C_AW) + ni * 16] = f2bf(v);
          }
    }
  } else if (EPI == EPI_LW || EPI == EPI_LA) {
    GF dst = (GF)(p.ws + (EPI == EPI_LW ? W_RWW : W_RWA));
    GCF bias = IN(EPI == EPI_LW ? I_RW0 : I_RA0);
#pragma unroll
    for (int ni = 0; ni < 4; ++ni) {
      const int col = cbase + ni * 16, d = col >> 8, jc = col & 255;
      const float b0 = bias[(ea.l * 2 + d) * 256 + jc];
#pragma unroll
      for (int mi = 0; mi < 4; ++mi)
#pragma unroll
        for (int j = 0; j < 4; ++j) {
          const float a = b0 + acc[mi][ni][j];
          float r;
          if (EPI == EPI_LW) { float wl = -softplusf_(-a) - 0.5f; r = __expf(-__expf(wl)); } else r = sigmoidf_(a);
          dst[((size_t)d * MT_ROWS + rbase + mi * 16 + j) * 256 + jc] = r;
        }
    }
  } else if (EPI == EPI_LG) {
    GF dst = (GF)(p.ws + W_RWG);
#pragma unroll
    for (int mi = 0; mi < 4; ++mi)
#pragma unroll
      for (int j = 0; j < 4; ++j)
#pragma unroll
        for (int ni = 0; ni < 4; ++ni) dst[(size_t)(rbase + mi * 16 + j) * 256 + cbase + ni * 16] = acc[mi][ni][j];
  } else if (EPI == EPI_Q) {
    GU qb = (GU)(p.ws + W_QB);
    const bool latent = m0 >= MCTX;
#pragma unroll
    for (int ni = 0; ni < 4; ++ni) {
      const int col = cbase + ni * 16;
      const int ctile = (n0 + wc * 64 + ni * 16) >> 4;
      const int tin = ctile % 6;
      const bool rope = latent && tin >= 4;
      const int i = (tin - 4) * 16 + fr;
      GCF rtab = (GCF)(p.ws + W_ROPE);
#pragma unroll
      for (int mi = 0; mi < 4; ++mi)
#pragma unroll
        for (int j = 0; j < 4; ++j) {
          const int row = rbase + mi * 16 + j;
          float v = acc[mi][ni][j];
          if (rope) {
            float pv = __shfl_xor(v, 8, 64);
            int t = (row - MCTX) & 4095;
            float cs = rtab[(t * 32 + i) * 2], sn = rtab[(t * 32 + i) * 2 + 1];
            v = (i & 8) ? (v * cs + pv * sn) : (v * cs - pv * sn);
          }
          qb[(size_t)row * 384 + col] = f2bf(v * QSCALE);
        }
    }
  } else if (EPI == EPI_KV) {
    GU kb = (GU)(p.ws + W_KB);
    GU vt = (GU)(p.ws + W_VT);
#pragma unroll
    for (int ni = 0; ni < 4; ++ni) {
      const int col = cbase + ni * 16, head = col >> 7, dd = col & 127;
#pragma unroll
      for (int mi = 0; mi < 4; ++mi) {
        const int row = rbase + mi * 16;
        if (dd < 64) {
#pragma unroll
          for (int j = 0; j < 4; ++j) kb[((size_t)(row + j) * 4 + head) * 96 + dd] = f2bf(acc[mi][ni][j]);
        } else {
          uint2 w; w.x = pack2(acc[mi][ni][0], acc[mi][ni][1]); w.y = pack2(acc[mi][ni][2], acc[mi][ni][3]);
          *(uint2*)(vt + (size_t)(head * 64 + dd - 64) * MKV + row) = w;
        }
      }
    }
  }
}

template <int EPI>
DEV void gemm_phase(const P& p, GCU A, int lda, GCU Bt, int ldb, int K, int MT, int NT, EpiArg ea, char* smem) {
  const int xcd = blockIdx.x & 7, slot = blockIdx.x >> 3, spx = gridDim.x >> 3;
  const int sbM = (MT + 7) >> 3, sbN = (NT + 7) >> 3, nsb = sbM * sbN;
  for (int sb = xcd; sb < nsb; sb += 8) {
    const int sm = sb % sbM, sn = sb / sbM;
    for (int idx = slot; idx < 64; idx += spx) {
      const int mt = sm * 8 + (idx & 7), nt = sn * 8 + (idx >> 3);
      if (mt < MT && nt < NT) gemm_tile<EPI>(p, A, lda, Bt, ldb, K, mt * 128, nt * 128, ea, smem);
    }
  }
}

DEV void gemm_res_phase(const P& p, GCU A, int lda, GCU Bt, int ldb, int K, EpiArg ea, char* smem) {
  const int xcd = blockIdx.x & 7, slot = blockIdx.x >> 3, spx = gridDim.x >> 3;
  for (int idx = slot; idx < 64; idx += spx) gemm_tile<EPI_RES>(p, A, lda, Bt, ldb, K, (xcd * 8 + (idx & 7)) * 128, (idx >> 3) * 128, ea, smem);
  const int sb = 8 + (xcd >> 1), kh = xcd & 1, Kh = K >> 1;
  for (int idx = slot; idx < 64; idx += spx) {
    const int m0 = (sb * 8 + (idx & 7)) * 128, n0 = (idx >> 3) * 128;
    if (kh == 0) gemm_tile<EPI_RES>(p, A, lda, Bt, ldb, Kh, m0, n0, ea, smem);
    else gemm_tile<EPI_RESD>(p, A + Kh, lda, Bt + Kh, ldb, Kh, m0, n0, ea, smem);
  }
}

DEV void rwkv_prep_item(const P& p, int l, int tile, char* smem) {
  GCF proj = (GCF)(p.ws + W_BIG);
  GF rwkk = (GF)(p.ws + W_RWKK);
  const int tid = tid_(), m0 = tile * 32, j = tid;
  const float kkp = IN(I_RKK)[l * 256 + j];
#pragma unroll
  for (int tb = 0; tb < 2; ++tb) {
    float kv[16];
#pragma unroll
    for (int i = 0; i < 16; ++i) kv[i] = proj[(size_t)(m0 + tb * 16 + i) * PLD + C_AK + j] * kkp;
#pragma unroll
    for (int i = 0; i < 16; ++i) {
      float ss = wave_sum(kv[i] * kv[i]);
      rwkk[(size_t)(m0 + tb * 16 + i) * 256 + j] = kv[i] / fmaxf(sqrtf(ss), 1e-12f);
    }
  }
}

DEV void rg_prep_item(const P& p, int l, int tile, char* smem) {
  typedef __attribute__((ext_vector_type(16))) float f32x16;
  float* us = (float*)smem;
  u16* ub = (u16*)(smem + 32768);
  GCF proj = (GCF)(p.ws + W_BIG);
  const int tid = tid_(), m0 = tile * 32, j = tid, g = tid >> 6, lane = tid & 63, l32 = lane & 31, lh = lane >> 5;
  const int s = m0 < MCTX ? (m0 >> 8) : 16 + ((m0 - MCTX) >> 12);
  const int r0 = seq_row0(s), T = seq_len(s);
  {
    const float cw0 = IN(I_CVW)[(l * 4 + 0) * 256 + j], cw1 = IN(I_CVW)[(l * 4 + 1) * 256 + j],
                cw2 = IN(I_CVW)[(l * 4 + 2) * 256 + j], cw3 = IN(I_CVW)[(l * 4 + 3) * 256 + j], cb = IN(I_CVB)[l * 256 + j];
    const int tb = m0 - r0;
    float xv[35];
#pragma unroll
    for (int i = 0; i < 35; ++i) { int t = tb + i - 2; xv[i] = (t >= 0 && t < T) ? proj[(size_t)(r0 + t) * PLD + C_CX + j] : 0.f; }
#pragma unroll
    for (int tok = 0; tok < 32; ++tok) {
      float u = cb + cw0 * xv[tok] + cw1 * xv[tok + 1] + cw2 * xv[tok + 2] + cw3 * xv[tok + 3];
      us[tok * 256 + j] = u; ub[tok * 264 + j] = f2bf(u);
    }
  }
  __syncthreads();
  GF rga = (GF)(p.ws + W_RGA); GF rgb = (GF)(p.ws + W_RGB);
  GF rgta = (GF)(p.ws + W_RGTA); GF rgtb = (GF)(p.ws + W_RGTB);
  bf16x8 af[4];
#pragma unroll
  for (int ks = 0; ks < 4; ++ks) af[ks] = *(const bf16x8*)(ub + l32 * 264 + g * 64 + ks * 16 + lh * 8);
#pragma unroll 1
  for (int dn = 0; dn < 4; ++dn) {
    const int d = dn >> 1, nb = dn & 1;
    f32x16 cr, ci;
#define RG_GATE(WIDX_, D_) do { \
      auto W = IN(WIDX_) + ((size_t)((l * 2 + d) * 4 + g)) * 4096; \
      _Pragma("unroll") for (int r = 0; r < 16; ++r) D_[r] = 0.f; \
      float wv[32]; \
      _Pragma("unroll") for (int ks = 0; ks < 4; ++ks) \
        _Pragma("unroll") for (int jj = 0; jj < 8; ++jj) wv[ks * 8 + jj] = W[(ks * 16 + lh * 8 + jj) * 64 + nb * 32 + l32]; \
      _Pragma("unroll") for (int ks = 0; ks < 4; ++ks) { \
        uint4 pw = make_uint4(pack2(wv[ks * 8 + 0], wv[ks * 8 + 1]), pack2(wv[ks * 8 + 2], wv[ks * 8 + 3]), pack2(wv[ks * 8 + 4], wv[ks * 8 + 5]), pack2(wv[ks * 8 + 6], wv[ks * 8 + 7])); \
        bf16x8 bfr = __builtin_bit_cast(bf16x8, pw); \
        D_ = __builtin_amdgcn_mfma_f32_32x32x16_bf16(af[ks], bfr, D_, 0, 0, 0); \
      } } while (0)
    RG_GATE(I_GWA, cr);
    RG_GATE(I_GWX, ci);
#undef RG_GATE
    {
      const int ch = g * 64 + nb * 32 + l32;
      const float ba = IN(I_GBA)[(l * 2 + d) * 256 + ch], bx = IN(I_GBX)[(l * 2 + d) * 256 + ch];
      const float spl = softplusf_(-IN(I_GLAM)[(l * 2 + d) * 256 + ch]);
      float sA[4], sB[4];
#pragma unroll
      for (int q = 0; q < 4; ++q) {
        float cA = 1.f, cB = 0.f;
#pragma unroll
        for (int rr = 0; rr < 4; ++rr) {
          const int r = q * 4 + rr, tok = 8 * q + 4 * lh + rr;
          const float rg = sigmoidf_(cr[r] + ba), ig = sigmoidf_(ci[r] + bx);
          const float la = -8.f * rg * spl;
          const float av = __expf(la);
          const float bv = sqrtf(fmaxf(1.f - av * av, 0.f)) * (ig * us[tok * 256 + ch]);
          rga[((size_t)d * MT_ROWS + m0 + tok) * 256 + ch] = av;
          rgb[((size_t)d * MT_ROWS + m0 + tok) * 256 + ch] = bv;
          if (d == 0) { cB = cB * av + bv; cA = cA * av; } else { cB = cB + cA * bv; cA = cA * av; }
        }
        sA[q] = cA; sB[q] = cB;
      }
      float oA[4], oB[4];
#pragma unroll
      for (int q = 0; q < 4; ++q) { oA[q] = __shfl_xor(sA[q], 32, 64); oB[q] = __shfl_xor(sB[q], 32, 64); }
      float cA = 1.f, cB = 0.f;
#pragma unroll
      for (int q8 = 0; q8 < 8; ++q8) {
        const bool mine = (q8 & 1) == lh;
        const float a_ = mine ? sA[q8 >> 1] : oA[q8 >> 1], b_ = mine ? sB[q8 >> 1] : oB[q8 >> 1];
        if (d == 0) { cB = cB * a_ + b_; cA = cA * a_; } else { cB = cB + cA * b_; cA = cA * a_; }
      }
      if (lh == 0) { rgta[((size_t)d * 384 + tile) * 256 + ch] = cA; rgtb[((size_t)d * 384 + tile) * 256 + ch] = cB; }
    }
  }
}

DEV void mla_prep_item(const P& p, int l, int item) {
  GCF proj = (GCF)(p.ws + W_BIG);
  GU cqn = (GU)(p.ws + W_CQN); GU ckvn = (GU)(p.ws + W_CKVN); GU kb = (GU)(p.ws + W_KB);
  const int lane = tid_() & 63, wid = tid_() >> 6;
  for (int r = 0; r < 16; ++r) {
    const int m = item * 64 + wid * 16 + r;
    if (m < MT_ROWS) {
      auto pr = proj + (size_t)m * PLD;
      float4 q = *(const float4*)(pr + C_BQ + lane * 4);
      float ss = wave_sum(q.x * q.x + q.y * q.y + q.z * q.z + q.w * q.w);
      float rs = rsqrtf(ss * (1.f / 256.f) + 1e-6f);
      float4 g = *(const float4*)(IN(I_QNG) + l * 256 + lane * 4);
      uint2 w; w.x = pack2(q.x * rs * g.x, q.y * rs * g.y); w.y = pack2(q.z * rs * g.z, q.w * rs * g.w);
      *(uint2*)(cqn + (size_t)m * 256 + lane * 4) = w;
      float2 c = *(const float2*)(pr + C_BKV + lane * 2);
      float s2 = wave_sum(c.x * c.x + c.y * c.y);
      float r2 = rsqrtf(s2 * (1.f / 128.f) + 1e-6f);
      float2 g2 = *(const float2*)(IN(I_KVNG) + l * 128 + lane * 2);
      float c0 = c.x * r2 * g2.x, c1 = c.y * r2 * g2.y;
      *(unsigned*)(ckvn + (size_t)m * 128 + lane * 2) = pack2(c0, c1);
      float pe = pr[C_BPE + (lane & 31)];
      float ppe = __shfl_xor(pe, 8, 64);
      float kv = pe;
      if (m < MCTX) {
        int b = m >> 8, t = m & 255;
        *(float2*)(OUTP + O_CKV + (((size_t)b * 4 + l) * 256 + t) * 128 + lane * 2) = make_float2(c0, c1);
        if (lane < 32) OUTP[O_KPE + (((size_t)b * 4 + l) * 256 + t) * 32 + lane] = pe;
      } else {
        int i = lane & 31, t = (m - MCTX) & 4095;
        float cs = ((GCF)(p.ws + W_ROPE))[(t * 32 + i) * 2], sn = ((GCF)(p.ws + W_ROPE))[(t * 32 + i) * 2 + 1];
        kv = (i & 8) ? (pe * cs + ppe * sn) : (pe * cs - ppe * sn);
      }
      if (lane < 32) {
        u16 kb16 = f2bf(kv);
#pragma unroll
        for (int hh = 0; hh < 4; ++hh) kb[((size_t)m * 4 + hh) * 96 + 64 + lane] = kb16;
      }
    } else {
      const int cr = m - MT_ROWS, b = cr >> 9, pp = cr & 511;
      float2 c = *(const float2*)(IN(I_CCKV) + (((size_t)b * 4 + l) * 512 + pp) * 128 + lane * 2);
      *(unsigned*)(ckvn + (size_t)m * 128 + lane * 2) = pack2(c.x, c.y);
      if (lane < 32) {
        u16 kb16 = f2bf(IN(I_CKPE)[(((size_t)b * 4 + l) * 512 + pp) * 32 + lane]);
#pragma unroll
        for (int hh = 0; hh < 4; ++hh) kb[((size_t)m * 4 + hh) * 96 + 64 + lane] = kb16;
      }
    }
  }
}

DEV void hg_decode(int item, int& s, int& c, int& d, int& h) {
  h = item & 3; d = (item >> 2) & 1; int ch = item >> 3;
  if (ch < 64) { s = ch >> 2; c = ch & 3; } else { s = 16 + ((ch - 64) >> 6); c = (ch - 64) & 63; }
}
template <bool WITHQ, int N>
DEV void hg_stage(const P& p, int l, int s, int d, int h, int i0, float* gs, float* vs, float* qs) {
  GCF proj = (GCF)(p.ws + W_BIG);
  GCF lbs = (GCF)(p.ws + W_LBS) + (l * 2 + d) * 256 + h * 64;
  const int r0 = seq_row0(s), T = seq_len(s), tid = tid_();
  const int k = tid & 63;
  const float lb = lbs[k];
  constexpr int NI = N / 4;
  float xf[NI], xv[NI], xq[NI];
#pragma unroll
  for (int u = 0; u < NI; ++u) {
    int i = (tid >> 6) + 4 * u;
    int t = d ? (T - 1 - (i0 + i)) : (i0 + i);
    auto pr = proj + (size_t)(r0 + t) * PLD;
    xf[u] = pr[C_DF + d * 256 + h * 64 + k]; xv[u] = pr[C_DI + h * 64 + k];
    if (WITHQ) xq[u] = pr[C_DQ + h * 64 + k];
  }
#pragma unroll
  for (int u = 0; u < NI; ++u) {
    int idx = ((tid >> 6) + 4 * u) * 64 + k;
    gs[idx] = lb + (1.f - lb) * sigmoidf_(xf[u]);
    vs[idx] = xv[u];
    if (WITHQ) qs[idx] = siluf_(xq[u]);
  }
}
DEV void hgrn_a_item(const P& p, int l, int item, char* smem) {
  typedef __attribute__((ext_vector_type(16))) float f32x16;
  float* gs = (float*)smem; float* vs = gs + 4096;
  float* part = vs + 4096;
  u16* wT = (u16*)(part + 256);
  u16* vT = wT + 64 * 72;
  int s, c, d, h; hg_decode(item, s, c, d, h);
  hg_stage<false, 64>(p, l, s, d, h, c * 64, gs, vs, nullptr);
  __syncthreads();
  const int tid = tid_(), k = tid & 63, qt = tid >> 6, lane = tid & 63, l32 = lane & 31, lh = lane >> 5;
  float lg[16], gk[16], loc = 0.f;
  unsigned vp[8];
#pragma unroll
  for (int u = 0; u < 16; ++u) { gk[u] = gs[(qt * 16 + u) * 64 + k]; lg[u] = __logf(fmaxf(gk[u], 1e-30f)); loc += lg[u]; }
#pragma unroll
  for (int u = 0; u < 8; ++u) vp[u] = pack2(vs[(qt * 16 + 2 * u) * 64 + k], vs[(qt * 16 + 2 * u + 1) * 64 + k]);
  part[qt * 64 + k] = loc;
  *(uint4*)(vT + k * 72 + qt * 16) = make_uint4(vp[0], vp[1], vp[2], vp[3]);
  *(uint4*)(vT + k * 72 + qt * 16 + 8) = make_uint4(vp[4], vp[5], vp[6], vp[7]);
  __syncthreads();
  float pre = 0.f, tot = 0.f;
#pragma unroll
  for (int q = 0; q < 4; ++q) { const float pv = part[q * 64 + k]; if (q < qt) pre += pv; tot += pv; }
  float run = pre;
  unsigned wp[8];
#pragma unroll
  for (int u = 0; u < 8; ++u) {
    run += lg[2 * u]; const float w0 = (1.f - gk[2 * u]) * __expf(tot - run);
    run += lg[2 * u + 1]; const float w1 = (1.f - gk[2 * u + 1]) * __expf(tot - run);
    wp[u] = pack2(w0, w1);
  }
  *(uint4*)(wT + k * 72 + qt * 16) = make_uint4(wp[0], wp[1], wp[2], wp[3]);
  *(uint4*)(wT + k * 72 + qt * 16 + 8) = make_uint4(wp[4], wp[5], wp[6], wp[7]);
  GF hS = (GF)(p.ws + W_HGS) + (size_t)item * 4096;
  GF hD = (GF)(p.ws + W_HGD) + (size_t)item * 64;
  if (qt == 0) hD[k] = __expf(tot);
  __syncthreads();
  const int kb = qt >> 1, vb = qt & 1;
  f32x16 acc;
#pragma unroll
  for (int r = 0; r < 16; ++r) acc[r] = 0.f;
#pragma unroll
  for (int ks = 0; ks < 4; ++ks) {
    const bf16x8 af = *(const bf16x8*)(wT + (kb * 32 + l32) * 72 + ks * 16 + lh * 8);
    const bf16x8 bfr = *(const bf16x8*)(vT + (vb * 32 + l32) * 72 + ks * 16 + lh * 8);
    acc = __builtin_amdgcn_mfma_f32_32x32x16_bf16(af, bfr, acc, 0, 0, 0);
  }
#pragma unroll
  for (int r = 0; r < 16; ++r) hS[(kb * 32 + (r & 3) + 8 * (r >> 2) + 4 * lh) * 64 + vb * 32 + l32] = acc[r];
}
DEV void hgrn_b_item(const P& p, int l, int item) {
  GF hS = (GF)(p.ws + W_HGS); GCF hD = (GCF)(p.ws + W_HGD);
  if (item < 128) {
    const int combo = item, s = combo >> 3, d = (combo >> 2) & 1, h = combo & 3, ch0 = s * 4;
#pragma unroll 1
    for (int ub = 0; ub < 4; ++ub) {
      float t[4][4], dd[4][4];
#pragma unroll
      for (int uu = 0; uu < 4; ++uu) {
        const int e = (ub * 4 + uu) * 256 + tid_();
#pragma unroll
        for (int u = 0; u < 4; ++u) { int it = ((ch0 + u) * 2 + d) * 4 + h; t[uu][u] = hS[(size_t)it * 4096 + e]; dd[uu][u] = hD[(size_t)it * 64 + (e >> 6)]; }
      }
#pragma unroll
      for (int uu = 0; uu < 4; ++uu) {
        const int e = (ub * 4 + uu) * 256 + tid_();
        float S = 0.f;
#pragma unroll
        for (int u = 0; u < 4; ++u) { int it = ((ch0 + u) * 2 + d) * 4 + h; hS[(size_t)it * 4096 + e] = S; S = dd[uu][u] * S + t[uu][u]; }
        OUTP[O_HGRN + ((((size_t)s * 4 + l) * 2 + d) * 4 + h) * 4096 + e] = S;
      }
    }
  } else {
    const int li = item - 128, combo = 128 + (li >> 4), e = (li & 15) * 256 + tid_();
    const int s = combo >> 3, d = (combo >> 2) & 1, h = combo & 3, ch0 = 64 + (s - 16) * 64, k = e >> 6;
    float S = IN(I_SHG)[((((size_t)(s - 16) * 4 + l) * 2 + d) * 4 + h) * 4096 + e];
    for (int c = 0; c < 64; c += 16) {
      float t[16], dd[16];
#pragma unroll
      for (int u = 0; u < 16; ++u) { int it = ((ch0 + c + u) * 2 + d) * 4 + h; t[u] = hS[(size_t)it * 4096 + e]; dd[u] = hD[(size_t)it * 64 + k]; }
#pragma unroll
      for (int u = 0; u < 16; ++u) { int it = ((ch0 + c + u) * 2 + d) * 4 + h; hS[(size_t)it * 4096 + e] = S; S = dd[u] * S + t[u]; }
    }
  }
}
DEV void hgrn_c_item(const P& p, int l, int item, char* smem) {
  float* gs = (float*)smem; float* vs = gs + 2048; float* qs = vs + 2048; float* part = qs + 2048;
  int s, c, d, h; hg_decode(item, s, c, d, h);
  const int tid = tid_(), v = tid & 63, kg = tid >> 6;
  GCF hS = (GCF)(p.ws + W_HGS2) + (size_t)item * 4096;
  GF hgo = (GF)(p.ws + W_HGO);
  const int r0 = seq_row0(s), T = seq_len(s);
  f2_ S[8];
#pragma unroll
  for (int j = 0; j < 8; ++j) { S[j].x = hS[(kg * 16 + 2 * j) * 64 + v]; S[j].y = hS[(kg * 16 + 2 * j + 1) * 64 + v]; }
  for (int half = 0; half < 2; ++half) {
    __syncthreads();
    hg_stage<true, 32>(p, l, s, d, h, c * 64 + half * 32, gs, vs, qs);
    __syncthreads();
#pragma unroll 4
    for (int i = 0; i < 32; ++i) {
      const float vv = vs[i * 64 + v];
      const f2_ vv2 = {vv, vv};
      f2_ o2 = {0.f, 0.f};
#pragma unroll
      for (int j4 = 0; j4 < 4; ++j4) {
        float4 g4 = *(const float4*)(gs + i * 64 + kg * 16 + j4 * 4);
        float4 q4 = *(const float4*)(qs + i * 64 + kg * 16 + j4 * 4);
        const f2_ ga = {g4.x, g4.y}, gb = {g4.z, g4.w}, qa = {q4.x, q4.y}, qb_ = {q4.z, q4.w};
        S[j4 * 2] = ga * (S[j4 * 2] - vv2) + vv2; o2 += qa * S[j4 * 2];
        S[j4 * 2 + 1] = gb * (S[j4 * 2 + 1] - vv2) + vv2; o2 += qb_ * S[j4 * 2 + 1];
      }
      part[(i * 4 + kg) * 64 + v] = o2.x + o2.y;
    }
    __syncthreads();
#pragma unroll
    for (int r = 0; r < 8; ++r) {
      int i = (tid >> 6) + 4 * r;
      float o = part[(i * 4 + 0) * 64 + v] + part[(i * 4 + 1) * 64 + v] + part[(i * 4 + 2) * 64 + v] + part[(i * 4 + 3) * 64 + v];
      int fi = c * 64 + half * 32 + i;
      int t = d ? (T - 1 - fi) : fi;
      hgo[((size_t)d * MT_ROWS + r0 + t) * 256 + h * 64 + v] = o;
    }
  }
}

DEV float geluf_(float x) { return 0.5f * x * (1.f + tanhf(0.7978845608028654f * (x + 0.044715f * x * x * x))); }
DEV void rg_scan_item(const P& p, int l, int tile, char* smem) {
  float* hf = (float*)smem;
  GCF proj = (GCF)(p.ws + W_BIG);
  GCF rga = (GCF)(p.ws + W_RGA); GCF rgb = (GCF)(p.ws + W_RGB);
  GCF rgta = (GCF)(p.ws + W_RGTA); GCF rgtb = (GCF)(p.ws + W_RGTB);
  GU mix = (GU)(p.ws + W_MIX);
  const int j = tid_(), m0 = tile * 32;
  const int s = m0 < MCTX ? (m0 >> 8) : 16 + ((m0 - MCTX) >> 12);
  const int t0 = seq_row0(s) >> 5, nt = seq_len(s) >> 5;
  float h = 0.f;
  if (s >= 16) h = IN(I_SRG)[(((size_t)(s - 16) * 4 + l) * 2 + 0) * 256 + j];
  {
    int tq = t0;
    for (; tq + 16 <= tile; tq += 16) {
      float ca[16], cb_[16];
#pragma unroll
      for (int u = 0; u < 16; ++u) { ca[u] = rgta[(size_t)(tq + u) * 256 + j]; cb_[u] = rgtb[(size_t)(tq + u) * 256 + j]; }
#pragma unroll
      for (int u = 0; u < 16; ++u) h = ca[u] * h + cb_[u];
    }
    for (; tq + 4 <= tile; tq += 4) {
      float ca[4], cb_[4];
#pragma unroll
      for (int u = 0; u < 4; ++u) { ca[u] = rgta[(size_t)(tq + u) * 256 + j]; cb_[u] = rgtb[(size_t)(tq + u) * 256 + j]; }
#pragma unroll
      for (int u = 0; u < 4; ++u) h = ca[u] * h + cb_[u];
    }
    for (; tq < tile; ++tq) h = rgta[(size_t)tq * 256 + j] * h + rgtb[(size_t)tq * 256 + j];
  }
  {
    float av[32], bv[32];
#pragma unroll
    for (int tok = 0; tok < 32; ++tok) { size_t o = (size_t)(m0 + tok) * 256 + j; av[tok] = rga[o]; bv[tok] = rgb[o]; }
#pragma unroll
    for (int tok = 0; tok < 32; ++tok) { h = av[tok] * h + bv[tok]; hf[tok * 256 + j] = h; }
  }
  if (s < 16 && tile == t0 + nt - 1) OUTP[O_RGLRU + (((size_t)s * 4 + l) * 2 + 0) * 256 + j] = h;
  h = 0.f;
  if (s >= 16) h = IN(I_SRG)[(((size_t)(s - 16) * 4 + l) * 2 + 1) * 256 + j];
  {
    int tq = t0 + nt - 1;
    for (; tq - 16 >= tile; tq -= 16) {
      float ca[16], cb_[16];
#pragma unroll
      for (int u = 0; u < 16; ++u) { ca[u] = rgta[((size_t)384 + tq - u) * 256 + j]; cb_[u] = rgtb[((size_t)384 + tq - u) * 256 + j]; }
#pragma unroll
      for (int u = 0; u < 16; ++u) h = ca[u] * h + cb_[u];
    }
    for (; tq - 4 >= tile; tq -= 4) {
      float ca[4], cb_[4];
#pragma unroll
      for (int u = 0; u < 4; ++u) { ca[u] = rgta[((size_t)384 + tq - u) * 256 + j]; cb_[u] = rgtb[((size_t)384 + tq - u) * 256 + j]; }
#pragma unroll
      for (int u = 0; u < 4; ++u) h = ca[u] * h + cb_[u];
    }
    for (; tq > tile; --tq) h = rgta[((size_t)384 + tq) * 256 + j] * h + rgtb[((size_t)384 + tq) * 256 + j];
  }
  {
    float av[32], bv[32], gt[32];
#pragma unroll
    for (int tok = 0; tok < 32; ++tok) { size_t o = ((size_t)MT_ROWS + m0 + tok) * 256 + j; av[tok] = rga[o]; bv[tok] = rgb[o]; gt[tok] = proj[(size_t)(m0 + tok) * PLD + C_CG + j]; }
#pragma unroll
    for (int tok = 31; tok >= 0; --tok) {
      h = av[tok] * h + bv[tok];
      mix[(size_t)(m0 + tok) * LDH + 512 + j] = f2bf((hf[tok * 256 + j] + h) * geluf_(gt[tok]));
    }
  }
  if (s < 16 && tile == t0) OUTP[O_RGLRU + (((size_t)s * 4 + l) * 2 + 1) * 256 + j] = h;
}

DEV void rwkv_scan_item(const P& p, int l, int s, int d, int h, int c, int nch, int g, char* smem) {
  float* buf = (float*)smem;
  float* opart = buf + 2 * 6144;
  GCF proj = (GCF)(p.ws + W_BIG);
  GCF rww = (GCF)(p.ws + W_RWW) + (size_t)d * MT_ROWS * 256;
  GCF rwa = (GCF)(p.ws + W_RWA) + (size_t)d * MT_ROWS * 256;
  GCF rwkk = (GCF)(p.ws + W_RWKK);
  const int tid = tid_(), lane = tid & 63, wid = tid >> 6, e = lane & 15;
  const bool isP = g >= 4;
  const int rowbase = (g & 3) * 16, rl = wid * 4 + (lane >> 4), row = rowbase + rl;
  const int r0 = seq_row0(s), T = seq_len(s), CL = T / nch, nck = CL >> 4, i0 = c * CL;
  auto outp = isP ? (GF)(p.ws + W_RWU) + ((size_t)d * 8192 - MCTX) * 256 : (GF)(p.ws + W_RWO) + (size_t)d * MT_ROWS * 256;
  const int lstep = tid >> 4, lq = (tid & 15) * 4, col = h * 64 + lq;
  const float4 ka4 = *(const float4*)(IN(I_RKA) + l * 256 + col);
  f2_ S01 = {0.f, 0.f}, S23 = {0.f, 0.f};
  if (isP) { S01.x = (e * 4 + 0 == row) ? 1.f : 0.f; S01.y = (e * 4 + 1 == row) ? 1.f : 0.f; S23.x = (e * 4 + 2 == row) ? 1.f : 0.f; S23.y = (e * 4 + 3 == row) ? 1.f : 0.f; }
  else if (c == 0 && s >= 16) {
    float4 st = *(const float4*)(IN(I_SRWKV) + ((((size_t)(s - 16) * 4 + l) * 2 + d) * 4 + h) * 4096 + row * 64 + e * 4);
    S01.x = st.x; S01.y = st.y; S23.x = st.z; S23.y = st.w;
  }
  const float vmask = isP ? 0.f : 1.f;
  float4 gr, gk, gv, gw, ga, gkk;
  auto gload = [&](int ck) {
    int ti = i0 + ck * 16 + lstep; int t = d ? (T - 1 - ti) : ti; size_t m = (size_t)(r0 + t);
    gr = *(const float4*)(proj + m * PLD + C_AR + col); gk = *(const float4*)(proj + m * PLD + C_AK + col); gv = *(const float4*)(proj + m * PLD + C_AV + col);
    gw = *(const float4*)(rww + m * 256 + col); ga = *(const float4*)(rwa + m * 256 + col); gkk = *(const float4*)(rwkk + m * 256 + col);
  };
  auto sstore = [&](int b) {
    float* bb = buf + b * 6144 + lstep * 64 + lq;
    float4 kd, kka;
    kd.x = gk.x * (1.f + (ga.x - 1.f) * ka4.x); kd.y = gk.y * (1.f + (ga.y - 1.f) * ka4.y); kd.z = gk.z * (1.f + (ga.z - 1.f) * ka4.z); kd.w = gk.w * (1.f + (ga.w - 1.f) * ka4.w);
    kka.x = gkk.x * ga.x; kka.y = gkk.y * ga.y; kka.z = gkk.z * ga.z; kka.w = gkk.w * ga.w;
    *(float4*)(bb) = gr; *(float4*)(bb + 1024) = gw; *(float4*)(bb + 2048) = kd; *(float4*)(bb + 3072) = gkk; *(float4*)(bb + 4096) = kka; *(float4*)(bb + 5120) = gv;
  };
  __syncthreads();
  gload(0); sstore(0);
  __syncthreads();
  for (int ck = 0; ck < nck; ++ck) {
    const int b = ck & 1;
    if (ck + 1 < nck) gload(ck + 1);
    const float* bb = buf + b * 6144 + e * 4;
    const float* bv = buf + b * 6144 + 5120 + row;
    float4 r4 = *(const float4*)(bb), w4 = *(const float4*)(bb + 1024), kd4 = *(const float4*)(bb + 2048), kk4 = *(const float4*)(bb + 3072), ka_ = *(const float4*)(bb + 4096);
    float vv = bv[0];
#pragma unroll
    for (int st = 0; st < 16; ++st) {
      float4 nr4, nw4, nkd4, nkk4, nka_; float nvv;
      if (st < 15) {
        nr4 = *(const float4*)(bb + (st + 1) * 64); nw4 = *(const float4*)(bb + 1024 + (st + 1) * 64); nkd4 = *(const float4*)(bb + 2048 + (st + 1) * 64);
        nkk4 = *(const float4*)(bb + 3072 + (st + 1) * 64); nka_ = *(const float4*)(bb + 4096 + (st + 1) * 64); nvv = bv[(st + 1) * 64];
      }
      const float vm = vv * vmask;
      const f2_ kk01 = {kk4.x, kk4.y}, kk23 = {kk4.z, kk4.w}, w01 = {w4.x, w4.y}, w23 = {w4.z, w4.w};
      const f2_ kd01 = {kd4.x, kd4.y}, kd23 = {kd4.z, kd4.w}, ka01 = {ka_.x, ka_.y}, ka23 = {ka_.z, ka_.w}, r01 = {r4.x, r4.y}, r23 = {r4.z, r4.w};
      f2_ dp = S01 * kk01 + S23 * kk23;
      const f2_ vm2 = {vm, vm};
      f2_ t01 = S01 * w01 + vm2 * kd01, t23 = S23 * w23 + vm2 * kd23;
      float pp = row16_sum(dp.x + dp.y);
      const f2_ pp2 = {pp, pp};
      S01 = t01 - pp2 * ka01; S23 = t23 - pp2 * ka23;
      f2_ od = S01 * r01 + S23 * r23;
      opart[(st * 16 + rl) * 16 + e] = od.x + od.y;
      if (st < 15) { r4 = nr4; w4 = nw4; kd4 = nkd4; kk4 = nkk4; ka_ = nka_; vv = nvv; }
    }
    {
      const int ost = lane >> 2, orr = lane & 3;
      const float* op = opart + ((ost * 16 + wid * 4 + orr) * 16);
      float4 a0 = *(const float4*)(op), a1 = *(const float4*)(op + 4), a2 = *(const float4*)(op + 8), a3 = *(const float4*)(op + 12);
      float o = ((a0.x + a0.y) + (a0.z + a0.w)) + ((a1.x + a1.y) + (a1.z + a1.w)) + ((a2.x + a2.y) + (a2.z + a2.w)) + ((a3.x + a3.y) + (a3.z + a3.w));
      int ti = i0 + ck * 16 + ost; int t = d ? (T - 1 - ti) : ti;
      outp[(size_t)(r0 + t) * 256 + h * 64 + rowbase + wid * 4 + orr] = o;
    }
    if (ck + 1 < nck) sstore(b ^ 1);
    __syncthreads();
  }
  const float4 Sf = make_float4(S01.x, S01.y, S23.x, S23.y);
  if (s < 16) *(float4*)(OUTP + O_RWKV + ((((size_t)s * 4 + l) * 2 + d) * 4 + h) * 4096 + row * 64 + e * 4) = Sf;
  else if (c + 1 < nch) {
    const int combo = ((s - 16) * 2 + d) * 4 + h;
    *(float4*)((GF)(p.ws + W_RWE) + (((size_t)combo * 4 + c) * 128 + (isP ? 64 : 0) + row) * 64 + e * 4) = Sf;
  }
}

DEV void rwkv_fix_item(const P& p, int l, int item, char* smem) {
  float* Sc = (float*)smem;
  float* Sn = Sc + 4160;
  float* us = Sn + 4160;
  const int combo = item / 24, rem = item % 24, c = 1 + rem / 8, sub = rem & 7;
  const int b = combo >> 3, d = (combo >> 2) & 1, h = combo & 3;
  GCF E = (GCF)(p.ws + W_RWE) + (size_t)combo * 4 * 8192;
  const int tid = tid_();
  __syncthreads();
  for (int i = tid; i < 4096; i += 256) Sc[(i >> 6) * 65 + (i & 63)] = E[i];
  __syncthreads();
  for (int cc = 1; cc < c; ++cc) {
    auto Es = E + (size_t)cc * 8192; auto Epg = Es + 4096;
    const int r = tid >> 2, jq = (tid & 3) * 16;
    float acc[16];
    {
      float4 pl0 = *(const float4*)(Epg + tid * 4), pl1 = *(const float4*)(Epg + 1024 + tid * 4), pl2 = *(const float4*)(Epg + 2048 + tid * 4), pl3 = *(const float4*)(Epg + 3072 + tid * 4);
#pragma unroll
      for (int j = 0; j < 16; ++j) acc[j] = Es[r * 64 + jq + j];
      *(float4*)(us + tid * 4) = pl0; *(float4*)(us + 1024 + tid * 4) = pl1; *(float4*)(us + 2048 + tid * 4) = pl2; *(float4*)(us + 3072 + tid * 4) = pl3;
    }
    __syncthreads();
    const float* Ep = us;
#pragma unroll 4
    for (int k = 0; k < 64; ++k) {
      const float sv = Sc[r * 65 + k];
      const float4 p0 = *(const float4*)(Ep + k * 64 + jq), p1 = *(const float4*)(Ep + k * 64 + jq + 4), p2 = *(const float4*)(Ep + k * 64 + jq + 8), p3 = *(const float4*)(Ep + k * 64 + jq + 12);
      acc[0] += sv * p0.x; acc[1] += sv * p0.y; acc[2] += sv * p0.z; acc[3] += sv * p0.w;
      acc[4] += sv * p1.x; acc[5] += sv * p1.y; acc[6] += sv * p1.z; acc[7] += sv * p1.w;
      acc[8] += sv * p2.x; acc[9] += sv * p2.y; acc[10] += sv * p2.z; acc[11] += sv * p2.w;
      acc[12] += sv * p3.x; acc[13] += sv * p3.y; acc[14] += sv * p3.z; acc[15] += sv * p3.w;
    }
#pragma unroll
    for (int j = 0; j < 16; ++j) Sn[r * 65 + jq + j] = acc[j];
    __syncthreads();
    for (int i = tid; i < 4160; i += 256) Sc[i] = Sn[i];
    __syncthreads();
  }
  const int T = 4096, CL = 1024, r0 = MCTX + b * 4096;
  GCF rwu = (GCF)(p.ws + W_RWU) + ((size_t)d * 8192 - MCTX) * 256;
  GF rwo = (GF)(p.ws + W_RWO) + (size_t)d * MT_ROWS * 256;
  const int ibase = c * CL + sub * 128;
  {
    float4 ub[8];
#pragma unroll
    for (int u = 0; u < 8; ++u) {
      int i = tid + 256 * u; int st = i >> 4, q4 = (i & 15) * 4;
      int ti = ibase + st; int t = d ? (T - 1 - ti) : ti;
      ub[u] = *(const float4*)(rwu + (size_t)(r0 + t) * 256 + h * 64 + q4);
    }
#pragma unroll
    for (int u = 0; u < 8; ++u) { int i = tid + 256 * u; *(float4*)(us + (i >> 4) * 64 + (i & 15) * 4) = ub[u]; }
  }
  __syncthreads();
  const int row = tid & 63, sg = tid >> 6;
  float srow[64];
#pragma unroll
  for (int k = 0; k < 64; ++k) srow[k] = Sc[row * 65 + k];
  for (int st = sg * 32; st < sg * 32 + 32; ++st) {
    const float* up = us + st * 64;
    float a = 0.f;
#pragma unroll
    for (int k4 = 0; k4 < 16; ++k4) { float4 u = *(const float4*)(up + k4 * 4); a += srow[k4 * 4] * u.x + srow[k4 * 4 + 1] * u.y + srow[k4 * 4 + 2] * u.z + srow[k4 * 4 + 3] * u.w; }
    int ti = ibase + st; int t = d ? (T - 1 - ti) : ti;
    auto o = rwo + (size_t)(r0 + t) * 256 + h * 64 + row;
    *o += a;
  }
}

DEV void attn_item(const P& p, int item, char* smem) {
  GCU qb = (GCU)(p.ws + W_QB); GCU kb = (GCU)(p.ws + W_KB); GCU vt = (GCU)(p.ws + W_VT);
  GU mix = (GU)(p.ws + W_MIX);
  constexpr int KS = 104, VS = 72;
  constexpr int STG = 64 * KS + 64 * VS;
  u16* lds = (u16*)smem;
  const int tid = tid_(), lane = tid & 63, wid = tid >> 6, fr = lane & 15, fq = lane >> 4;
  int h, qrow0, nkt, kbase, cbase;
  if (item < 256) { int b = item >> 7, rem = item & 127; h = rem >> 5; qrow0 = MCTX + b * 4096 + (rem & 31) * 128; nkt = 72; kbase = MCTX + b * 4096; cbase = MT_ROWS + b * 512; }
  else { int it = item - 256, s = it >> 3, rem = it & 7; h = rem >> 1; qrow0 = s * 256 + (rem & 1) * 128; nkt = 4; kbase = s * 256; cbase = 0; }
  bf16x8 Qf[2][3];
#pragma unroll
  for (int qg = 0; qg < 2; ++qg)
#pragma unroll
    for (int ks = 0; ks < 3; ++ks) Qf[qg][ks] = *(const bf16x8*)(qb + (size_t)(qrow0 + wid * 32 + qg * 16 + fr) * 384 + h * 96 + ks * 32 + fq * 8);
  f32x4 O[2][4];
#pragma unroll
  for (int qg = 0; qg < 2; ++qg)
#pragma unroll
    for (int dv = 0; dv < 4; ++dv) O[qg][dv] = (f32x4){0.f, 0.f, 0.f, 0.f};
  float mrun[2] = {-1e30f, -1e30f}, lrun[2] = {0.f, 0.f};
  uint4 gk0, gk1, gk2, gv0, gv1;
  const int kr0 = tid / 12, kc0 = tid % 12, kr1 = (tid + 256) / 12, kc1 = (tid + 256) % 12, kr2 = (tid + 512) / 12, kc2 = (tid + 512) % 12;
  const int vr0 = tid >> 3, vc0 = tid & 7, vr1 = vr0 + 32;
#define A_GLOAD(kt_) do { const int krow0_ = (kt_) < 64 ? kbase + (kt_) * 64 : cbase + ((kt_) - 64) * 64; \
    gk0 = *(const uint4*)(kb + ((size_t)(krow0_ + kr0) * 4 + h) * 96 + kc0 * 8); \
    gk1 = *(const uint4*)(kb + ((size_t)(krow0_ + kr1) * 4 + h) * 96 + kc1 * 8); \
    gk2 = *(const uint4*)(kb + ((size_t)(krow0_ + kr2) * 4 + h) * 96 + kc2 * 8); \
    gv0 = *(const uint4*)(vt + (size_t)(h * 64 + vr0) * MKV + krow0_ + vc0 * 8); \
    gv1 = *(const uint4*)(vt + (size_t)(h * 64 + vr1) * MKV + krow0_ + vc0 * 8); } while (0)
#define A_SSTORE(b_) do { u16* kd_ = lds + (b_) * STG; u16* vd_ = kd_ + 64 * KS; \
    *(uint4*)(kd_ + kr0 * KS + kc0 * 8) = gk0; *(uint4*)(kd_ + kr1 * KS + kc1 * 8) = gk1; *(uint4*)(kd_ + kr2 * KS + kc2 * 8) = gk2; \
    { const int sub_ = vc0 >> 2, G0_ = (vc0 & 3) * 2, G1_ = G0_ + 1; \
      *(uint2*)(vd_ + vr0 * VS + sub_ * 32 + (G0_ & 3) * 8 + (G0_ >> 2) * 4) = make_uint2(gv0.x, gv0.y); \
      *(uint2*)(vd_ + vr0 * VS + sub_ * 32 + (G1_ & 3) * 8 + (G1_ >> 2) * 4) = make_uint2(gv0.z, gv0.w); \
      *(uint2*)(vd_ + vr1 * VS + sub_ * 32 + (G0_ & 3) * 8 + (G0_ >> 2) * 4) = make_uint2(gv1.x, gv1.y); \
      *(uint2*)(vd_ + vr1 * VS + sub_ * 32 + (G1_ & 3) * 8 + (G1_ >> 2) * 4) = make_uint2(gv1.z, gv1.w); } } while (0)
  __syncthreads();
  A_GLOAD(0);
  A_SSTORE(0);
  __syncthreads();
  for (int kt = 0; kt < nkt; ++kt) {
    const int bsel = kt & 1;
    if (kt + 1 < nkt) A_GLOAD(kt + 1);
    const u16* kl = lds + bsel * STG;
    const u16* vl = kl + 64 * KS;
#pragma unroll
    for (int st = 0; st < 2; ++st) {
      bf16x8 Kf[2][3];
#pragma unroll
      for (int sub = 0; sub < 2; ++sub)
#pragma unroll
        for (int ks = 0; ks < 3; ++ks) Kf[sub][ks] = *(const bf16x8*)(kl + (st * 32 + sub * 16 + fr) * KS + ks * 32 + fq * 8);
      bf16x8 Vf[4];
#pragma unroll
      for (int dv = 0; dv < 4; ++dv) Vf[dv] = *(const bf16x8*)(vl + (dv * 16 + fr) * VS + st * 32 + fq * 8);
#pragma unroll
      for (int qg = 0; qg < 2; ++qg) {
        f32x4 sc[2];
#pragma unroll
        for (int sub = 0; sub < 2; ++sub) {
          sc[sub] = (f32x4){0.f, 0.f, 0.f, 0.f};
#pragma unroll
          for (int ks = 0; ks < 3; ++ks) sc[sub] = __builtin_amdgcn_mfma_f32_16x16x32_bf16(Kf[sub][ks], Qf[qg][ks], sc[sub], 0, 0, 0);
        }
        float mx = fmaxf(fmaxf(fmaxf(sc[0][0], sc[0][1]), fmaxf(sc[0][2], sc[0][3])), fmaxf(fmaxf(sc[1][0], sc[1][1]), fmaxf(sc[1][2], sc[1][3])));
        mx = xrow_max(mx);
        const float mn = fmaxf(mrun[qg], mx);
        const float alpha = __builtin_amdgcn_exp2f(mrun[qg] - mn);
        mrun[qg] = mn;
        float pv[8], ps = 0.f;
#pragma unroll
        for (int sub = 0; sub < 2; ++sub)
#pragma unroll
          for (int j = 0; j < 4; ++j) { pv[sub * 4 + j] = __builtin_amdgcn_exp2f(sc[sub][j] - mn); ps += pv[sub * 4 + j]; }
        lrun[qg] = lrun[qg] * alpha + ps;
        uint4 pw = make_uint4(pack2(pv[0], pv[1]), pack2(pv[2], pv[3]), pack2(pv[4], pv[5]), pack2(pv[6], pv[7]));
        bf16x8 pb = __builtin_bit_cast(bf16x8, pw);
        if (__builtin_amdgcn_ballot_w64(alpha < 1.f)) {
#pragma unroll
          for (int dv = 0; dv < 4; ++dv) { O[qg][dv][0] *= alpha; O[qg][dv][1] *= alpha; O[qg][dv][2] *= alpha; O[qg][dv][3] *= alpha; }
        }
#pragma unroll
        for (int dv = 0; dv < 4; ++dv) O[qg][dv] = __builtin_amdgcn_mfma_f32_16x16x32_bf16(Vf[dv], pb, O[qg][dv], 0, 0, 0);
      }
    }
    if (kt + 1 < nkt) A_SSTORE(bsel ^ 1);
    __syncthreads();
  }
#undef A_GLOAD
#undef A_SSTORE
#pragma unroll
  for (int qg = 0; qg < 2; ++qg) {
    const float inv = 1.f / xrow_sum(lrun[qg]);
    const size_t row = (size_t)(qrow0 + wid * 32 + qg * 16 + fr);
#pragma unroll
    for (int dv = 0; dv < 4; ++dv) {
      uint2 w; w.x = pack2(O[qg][dv][0] * inv, O[qg][dv][1] * inv); w.y = pack2(O[qg][dv][2] * inv, O[qg][dv][3] * inv);
      *(uint2*)(mix + row * LDH + 256 + h * 64 + dv * 16 + fq * 4) = w;
    }
  }
}

DEV void post_item(const P& p, int l, int item) {
  GCF proj = (GCF)(p.ws + W_BIG);
  GCF rwa = (GCF)(p.ws + W_RWA); GCF rwo = (GCF)(p.ws + W_RWO);
  GCF rwg = (GCF)(p.ws + W_RWG); GCF hgo = (GCF)(p.ws + W_HGO);
  GU mix = (GU)(p.ws + W_MIX);
  const int j = tid_();
  const float ka = IN(I_RKA)[l * 256 + j], rk = IN(I_RRK)[l * 256 + j], gng = IN(I_RGNG)[l * 256 + j], gnb = IN(I_RGNB)[l * 256 + j];
  const float hgg = IN(I_HGN)[l * 256 + j];
#pragma unroll 1
  for (int tb = 0; tb < 4; ++tb) {
    float r[4], k[4], v[4], a0[4], a1[4], o0[4], o1[4], g[4], h0[4], h1[4], xg[4];
#pragma unroll
    for (int i = 0; i < 4; ++i) {
      const size_t m = (size_t)item * 16 + tb * 4 + i;
      auto pr = proj + m * PLD;
      r[i] = pr[C_AR + j]; k[i] = pr[C_AK + j]; v[i] = pr[C_AV + j]; xg[i] = pr[C_DG + j];
      a0[i] = rwa[m * 256 + j]; a1[i] = rwa[((size_t)MT_ROWS + m) * 256 + j];
      o0[i] = rwo[m * 256 + j]; o1[i] = rwo[((size_t)MT_ROWS + m) * 256 + j];
      g[i] = rwg[m * 256 + j]; h0[i] = hgo[m * 256 + j]; h1[i] = hgo[((size_t)MT_ROWS + m) * 256 + j];
    }
#pragma unroll
    for (int i = 0; i < 4; ++i) {
      const size_t m = (size_t)item * 16 + tb * 4 + i;
      float kd0 = k[i] * (1.f + (a0[i] - 1.f) * ka), kd1 = k[i] * (1.f + (a1[i] - 1.f) * ka);
      float bsum = wave_sum(r[i] * (kd0 + kd1) * rk);
      float of = o0[i] + o1[i];
      float mu = wave_sum(of) * (1.f / 64.f);
      float dv = of - mu;
      float var = wave_sum(dv * dv) * (1.f / 64.f);
      float gn = dv * rsqrtf(var + 64e-5f) * gng + gnb;
      float y = (gn + bsum * v[i]) * g[i];
      mix[m * LDH + j] = f2bf(y);
      float o = h0[i] + h1[i];
      float rs = rsqrtf(wave_sum(o * o) * (1.f / 64.f) + 1e-6f);
      mix[m * LDH + 768 + j] = f2bf(o * rs * hgg * siluf_(xg[i]));
    }
  }
}

constexpr int NPH = 2 + 4 * 12;
__global__ void __launch_bounds__(256, 2) fwd_kernel(P p0, int ph0, int ph1) {
  P p = p0;
  __shared__ __attribute__((aligned(16))) char smem[73728];
  __shared__ uint4 xbw;
  __shared__ int s_item;
  cg::grid_group grid = cg::this_grid();
  if (p.never) grid.sync();
  unsigned* bar = (unsigned*)(p0.ws + W_BAR);
  unsigned* ctr = (unsigned*)(p0.ws + W_CTR);
  const bool multi = (ph1 - ph0) > 1;
  XcdBarrier xb; xb.bar = bar; xb.x = 0; xb.st = (volatile unsigned*)&xbw;
  if (multi) {
    if (tid_() == 0) xbw = make_uint4(0u, 0u, 0u, 0u);
    __syncthreads();
    xb.x = xb_xcc_id();
    if (tid_() == 0) (void)xb_add(&bar[XB_XCNT(xb.x)], 1u);
  }
  for (int ph = ph0; ph < ph1; ++ph) {
    { char* w_ = p0.ws; float* o_ = p0.out; asm volatile("" : "+s"(w_), "+s"(o_)); p.ws = w_; p.out = o_; }
    GCU hbuf = (GCU)(p.ws + W_H);
    GCU actb = (GCU)(p.ws + W_BIG);
    if (ph == 0) phase_setup0(p, smem);
    else if (ph == 1) phase_setup1(p);
    else {
      const int l = (ph - 2) / 12, q = (ph - 2) % 12;
      unsigned* pc = ctr + ph * 64;
      if (q == 0 || q == 9) {
        const int jf = q == 0 ? 0 : 1;
        gemm_phase<EPI_ACT>(p, hbuf, LDH, (GCU)(p.ws + W_WFI) + (size_t)(l * 2 + jf) * 5632 * LDH, LDH, 1024, 96, 44, EpiArg{l, 0, 0.f}, smem);
      } else if (q == 1 || q == 10) {
        const int jf = q == 1 ? 0 : 1;
        gemm_res_phase(p, actb, LDF, (GCU)(p.ws + W_WFO) + (size_t)(l * 2 + jf) * 1024 * LDF, LDF, DFF, EpiArg{l, jf == 0 ? 2 : 8, 0.5f}, smem);
      } else if (q == 2) phase_ln(p, l, 0, l, 3, false);
      else if (q == 8) phase_ln(p, l, 1, l, 6, false);
      else if (q == 11) phase_ln(p, l, 2, l < 3 ? l + 1 : l, 0, l == 3);
      else if (q == 3) {
        gemm_phase<EPI_PROJ>(p, hbuf, LDH, (GCU)(p.ws + W_WIN) + (size_t)l * PLD * LDH, LDH, 1024, 96, 27, EpiArg{l, 0, 0.f}, smem);
      } else if (q == 4) {
        for (;;) {
          int it = next_item(pc, &s_item);
          if (it >= 3472) break;
          if (it < 384) rg_prep_item(p, l, it, smem);
          else if (it < 768) { int t = it - 384; gemm_tile<EPI_LW>(p, (GCU)(p.ws + W_LIN), 384, (GCU)(p.ws + W_LW) + (size_t)l * 512 * 128, 128, 128, (t >> 2) * 128, (t & 3) * 128, EpiArg{l, 0, 0.f}, smem); }
          else if (it < 1152) { int t = it - 768; gemm_tile<EPI_LA>(p, (GCU)(p.ws + W_LIN) + 128, 384, (GCU)(p.ws + W_LA) + (size_t)l * 512 * 128, 128, 128, (t >> 2) * 128, (t & 3) * 128, EpiArg{l, 0, 0.f}, smem); }
          else if (it < 1344) { int t = it - 1152; gemm_tile<EPI_LG>(p, (GCU)(p.ws + W_LIN) + 256, 384, (GCU)(p.ws + W_LG) + (size_t)l * 256 * 128, 128, 128, (t >> 1) * 128, (t & 1) * 128, EpiArg{l, 0, 0.f}, smem); }
          else if (it < 1728) rwkv_prep_item(p, l, it - 1344, smem);
          else if (it < 1936) mla_prep_item(p, l, it - 1728);
          else hgrn_a_item(p, l, it - 1936, smem);
        }
      } else if (q == 5) {
        enum { Q0 = 0, KV0 = Q0 + 96, RW0 = KV0 + 104, HB0 = RW0 + 448, AT0 = HB0 + 384, RG0 = AT0 + 256, RC0 = RG0 + 384, FX0 = RC0 + 512,
               AC0 = FX0 + 384, HC0 = AC0 + 128, END0 = HC0 + 1536, NGEMM = 200 };
        for (;;) {
          int it = next_item(pc, &s_item);
          if (it >= END0) break;
          if (it < KV0) {
#pragma unroll 1
            for (int nt = 0; nt < 3; ++nt) gemm_tile<EPI_Q>(p, (GCU)(p.ws + W_CQN), 256, (GCU)(p.ws + W_WUQ) + (size_t)l * 384 * 256, 256, 256, it * 128, nt * 128, EpiArg{l, 0, 0.f}, smem);
            item_publish(pc + 16);
          } else if (it < RW0) {
            const int t = it - KV0;
#pragma unroll 1
            for (int nt = 0; nt < 4; ++nt) gemm_tile<EPI_KV>(p, (GCU)(p.ws + W_CKVN), 128, (GCU)(p.ws + W_WUKV) + (size_t)l * 512 * 128, 128, 128, t * 128, nt * 128, EpiArg{l, 0, 0.f}, smem);
            item_publish(pc + 16);
          } else if (it < HB0) {
            int t = it - RW0, combo = t / 28, r = t % 28;
            int c = r < 4 ? 0 : 1 + (r - 4) / 8, g = r < 4 ? r : (r - 4) & 7;
            rwkv_scan_item(p, l, 16 + (combo >> 3), (combo >> 2) & 1, combo & 3, c, 4, g, smem);
            item_publish(pc + 40 + combo);
          }
          else if (it < AT0) { hgrn_b_item(p, l, it - HB0); item_publish(pc + 32); }
          else if (it < RG0) { item_wait(pc + 16, NGEMM); attn_item(p, it - AT0, smem); }
          else if (it < RC0) rg_scan_item(p, l, it - RG0, smem);
          else if (it < FX0) { int t = it - RC0; rwkv_scan_item(p, l, t >> 5, (t >> 4) & 1, (t >> 2) & 3, 0, 1, t & 3, smem); }
          else if (it < AC0) { int t = it - FX0; item_wait(pc + 40 + t / 24, 28u); rwkv_fix_item(p, l, t, smem); }
          else if (it < HC0) { item_wait(pc + 16, NGEMM); attn_item(p, it - AC0 + 256, smem); }
          else { item_wait(pc + 32, 384u); hgrn_c_item(p, l, it - HC0, smem); }
        }
      } else if (q == 6) {
        for (;;) {
          int it = next_item(pc, &s_item);
          if (it >= 768) break;
          post_item(p, l, it);
        }
      } else if (q == 7) {
        gemm_res_phase(p, (GCU)(p.ws + W_MIX), LDH, (GCU)(p.ws + W_WOUT) + (size_t)l * 1024 * LDH, LDH, 1024, EpiArg{l, 5, 1.0f}, smem);
      }
    }
    if (multi && ph + 1 < ph1) xcd_barrier(xb);
  }
}

#ifndef SINGLE_LAUNCH
#define SINGLE_LAUNCH 1
#endif

extern "C" void kernel_launch(void* const* d_in, const int* in_sizes, int n_in, void* d_out, int out_size, void* d_ws, size_t ws_size,
                              hipStream_t stream) {
  if (ws_size < W_END || n_in < 40) { fprintf(stderr, "workspace too small: %zu < %zu\n", ws_size, (size_t)W_END); return; }
  static int grid_blocks = 0;
  if (!grid_blocks) {
    int dev = 0, cus = 0, per_cu = 0;
    hipGetDevice(&dev);
    hipDeviceGetAttribute(&cus, hipDeviceAttributeMultiprocessorCount, dev);
    hipOccupancyMaxActiveBlocksPerMultiprocessor(&per_cu, fwd_kernel, 256, 0);
    if (per_cu > 2) per_cu = 2;
    if (per_cu < 1) per_cu = 1;
    grid_blocks = cus * per_cu;
  }
  P p{};
  for (int i = 0; i < 40; ++i) p.in[i] = (const float*)d_in[i];
  p.out = (float*)d_out; p.ws = (char*)d_ws; p.never = 0; p.pad = 0;
  hipMemsetAsync(d_ws, 0, 32768, stream);
#if SINGLE_LAUNCH
  int ph0 = 0, ph1 = NPH;
  void* args[] = {&p, &ph0, &ph1};
  hipError_t e = hipLaunchCooperativeKernel((void*)fwd_kernel, dim3(grid_blocks), dim3(256), args, 0, stream);
  if (e != hipSuccess) fprintf(stderr, "cooperative launch failed: %s (grid %d)\n", hipGetErrorString(e), grid_blocks);
#else
  for (int ph = 0; ph < NPH; ++ph) fwd_kernel<<<grid_blocks, 256, 0, stream>>>(p, ph, ph + 1);
#endif
}
```

```cpp
#include <hip/hip_runtime.h>
#include <hip/hip_bf16.h>
#include <hip/hip_cooperative_groups.h>
#include <cstdio>
#include <cstdint>
namespace cg = cooperative_groups;

#define DEV __device__ __forceinline__
typedef unsigned short u16;
#define AS1 __attribute__((address_space(1)))
typedef AS1 float* GF; typedef const AS1 float* GCF; typedef AS1 u16* GU; typedef const AS1 u16* GCU;
typedef const AS1 float4* GCF4; typedef AS1 float4* GF4; typedef const AS1 float2* GCF2; typedef AS1 float2* GF2;
typedef const AS1 uint4* GCU4; typedef AS1 uint4* GU4; typedef const AS1 uint2* GCU2; typedef AS1 uint2* GU2; typedef AS1 unsigned* GUI;
typedef float f4v_ __attribute__((ext_vector_type(4)));
__device__ __forceinline__ float4 ldg4(GCF q) { f4v_ v = *(const AS1 f4v_*)q; return make_float4(v.x, v.y, v.z, v.w); }
#define IN(i) ((GCF)p.in[i])
#define OUTP ((GF)p.out)
typedef __attribute__((ext_vector_type(8))) short bf16x8;
typedef __attribute__((ext_vector_type(4))) float f32x4;
typedef float f2_ __attribute__((ext_vector_type(2)));

constexpr int LDH = 1088, LDF = 2880;
constexpr int DM = 1024, MT_ROWS = 12288, MCTX = 4096, MKV = 13312, DFF = 2816, DIN = 3360, PLD = 3456;
constexpr float ALPHA = 1.6817928305074292f;
constexpr float QSCALE = 0.10206207261596575f * 1.4426950408889634f;
constexpr int C_AR = 0, C_AK = 256, C_AV = 512, C_AW = 768, C_AA = 896, C_AG = 1024, C_BQ = 1152, C_BKV = 1408, C_BPE = 1536,
              C_CX = 1568, C_CG = 1824, C_DQ = 2080, C_DF = 2336, C_DI = 2848, C_DG = 3104;
enum { I_XP = 0, I_XS, I_CCKV, I_CKPE, I_SRWKV, I_SRG, I_SHG, I_C, I_CCTX, I_WADA, I_BADA, I_LNG, I_LNB, I_WFI, I_WFO, I_WIN, I_WOUT,
       I_RW0, I_RW2, I_RA0, I_RA2, I_RG2, I_RKK, I_RKA, I_RRK, I_RGNG, I_RGNB, I_QNG, I_WUQ, I_KVNG, I_WUKV,
       I_CVW, I_CVB, I_GWA, I_GBA, I_GWX, I_GBX, I_GLAM, I_HLB, I_HGN };
constexpr size_t O_Y = 0, O_CKV = 12582912, O_KPE = 14680064, O_RWKV = 15204352, O_RGLRU = 17301504, O_HGRN = 17334272;

constexpr size_t al256(size_t x) { return (x + 255) & ~(size_t)255; }
constexpr size_t W_BAR = 0;
constexpr size_t W_CTR = 16384;
constexpr size_t W_WFI = 32768;
constexpr size_t W_WFO = W_WFI + (size_t)4 * 2 * 5632 * LDH * 2;
constexpr size_t W_WIN = W_WFO + (size_t)4 * 2 * 1024 * LDF * 2;
constexpr size_t W_WOUT = W_WIN + (size_t)4 * 3456 * LDH * 2;
constexpr size_t W_WUQ = W_WOUT + (size_t)4 * 1024 * LDH * 2;
constexpr size_t W_WUKV = W_WUQ + (size_t)4 * 384 * 256 * 2;
constexpr size_t W_MODS = W_WUKV + (size_t)4 * 512 * 128 * 2;
constexpr size_t W_LBS = W_MODS + (size_t)4 * 3 * 9216 * 4;
constexpr size_t W_X = W_LBS + 8192;
constexpr size_t W_H = W_X + (size_t)MT_ROWS * 1024 * 4;
constexpr size_t W_BIG = W_H + (size_t)MT_ROWS * LDH * 2;
constexpr size_t W_MIX = W_BIG + (size_t)MT_ROWS * PLD * 4;
constexpr size_t SZ_T = (size_t)MT_ROWS * 256 * 4;
constexpr size_t W_RWW = W_MIX + (size_t)MT_ROWS * LDH * 2;
constexpr size_t W_RWA = W_RWW + 2 * SZ_T;
constexpr size_t W_RWKK = W_RWA + 2 * SZ_T;
constexpr size_t W_RWG = W_RWKK + SZ_T;
constexpr size_t W_RWO = W_RWG + SZ_T;
constexpr size_t W_RGA = W_RWO + 2 * SZ_T;
constexpr size_t W_RGB = W_RGA + 2 * SZ_T;
constexpr size_t W_RGTA = W_RGB + 2 * SZ_T;
constexpr size_t W_RGTB = W_RGTA + (size_t)2 * 384 * 256 * 4;
constexpr size_t W_HGO = W_RGTB + (size_t)2 * 384 * 256 * 4;
constexpr size_t W_HGS = W_HGO + 2 * SZ_T;
constexpr size_t W_HGD = W_HGS + (size_t)1536 * 4096 * 4;
constexpr size_t W_CQN = W_HGD + (size_t)1536 * 64 * 4;
constexpr size_t W_CKVN = W_CQN + (size_t)MT_ROWS * 256 * 2;
constexpr size_t W_QB = W_CKVN + (size_t)MKV * 128 * 2;
constexpr size_t W_KB = W_QB + (size_t)MT_ROWS * 384 * 2;
constexpr size_t W_VT = W_KB + (size_t)MKV * 384 * 2;
constexpr size_t W_HGS2 = W_HGS;
constexpr size_t W_RWU = W_VT + (size_t)4 * 64 * MKV * 2;
constexpr size_t W_RWE = W_RWU + (size_t)2 * 8192 * 256 * 4;
constexpr size_t W_ROPE = W_RWE + (size_t)16 * 4 * 128 * 64 * 4;
constexpr size_t W_LW = W_ROPE + (size_t)4096 * 32 * 8;
constexpr size_t W_LA = W_LW + (size_t)4 * 512 * 128 * 2;
constexpr size_t W_LG = W_LA + (size_t)4 * 512 * 128 * 2;
constexpr size_t W_END = W_LG + (size_t)4 * 256 * 128 * 2;
constexpr size_t W_XD = W_BIG + (size_t)80 * 1024 * 1024;
constexpr size_t W_LIN = W_MIX;

struct P {
  const float* in[40];
  float* out;
  char* ws;
  int never;
  int pad;
};

DEV int tid_() { int t = __builtin_amdgcn_workitem_id_x(); asm volatile("" : "+v"(t)); return t; }
DEV unsigned pack2(float a, float b) { unsigned r; asm("v_cvt_pk_bf16_f32 %0, %1, %2" : "=v"(r) : "v"(a), "v"(b)); return r; }
DEV u16 f2bf(float f) { return (u16)(pack2(f, f) & 0xffffu); }
DEV float bf2f(u16 b) { return __uint_as_float(((unsigned)b) << 16); }
DEV float sigmoidf_(float x) { return 1.f / (1.f + __expf(-x)); }
DEV float siluf_(float x) { return x / (1.f + __expf(-x)); }
DEV float softplusf_(float x) { return fmaxf(x, 0.f) + __logf(1.f + __expf(-fabsf(x))); }
DEV float tanhf_(float x) { float e = __expf(2.f * x); return 1.f - 2.f / (e + 1.f); }
template <int CTRL> DEV float dppf(float x) {
  return __builtin_bit_cast(float, __builtin_amdgcn_update_dpp(0, __builtin_bit_cast(int, x), CTRL, 0xf, 0xf, false));
}
DEV float row16_sum(float x) {
  x += dppf<0x121>(x); x += dppf<0x122>(x); x += dppf<0x124>(x); x += dppf<0x128>(x);
  return x;
}
DEV float xrow_max(float x) {
  auto s = __builtin_amdgcn_permlane16_swap(__float_as_uint(x), __float_as_uint(x), false, false);
  x = fmaxf(__uint_as_float(s[0]), __uint_as_float(s[1]));
  auto t = __builtin_amdgcn_permlane32_swap(__float_as_uint(x), __float_as_uint(x), false, false);
  return fmaxf(__uint_as_float(t[0]), __uint_as_float(t[1]));
}
DEV float xrow_sum(float x) {
  auto s = __builtin_amdgcn_permlane16_swap(__float_as_uint(x), __float_as_uint(x), false, false);
  x = __uint_as_float(s[0]) + __uint_as_float(s[1]);
  auto t = __builtin_amdgcn_permlane32_swap(__float_as_uint(x), __float_as_uint(x), false, false);
  return __uint_as_float(t[0]) + __uint_as_float(t[1]);
}
DEV float wave_sum(float v) { return xrow_sum(row16_sum(v)); }
DEV int cond_idx(int m) { return m < MCTX ? 0 : 1 + ((m - MCTX) >> 12); }
DEV int seq_row0(int s) { return s < 16 ? s * 256 : MCTX + (s - 16) * 4096; }
DEV int seq_len(int s) { return s < 16 ? 256 : 4096; }

#define XB_TMO      128
#define XB_XCNT(j)  (256  + 64 * (j))
#define XB_XSUB(j)  (1280 + 64 * (j))
#define XB_XGEN(j)  (2304 + 64 * (j))
#define XB_TOP      3328
#define XB_TOPGEN   3392
#define XB_SPIN_CAP (1u << 22)
DEV unsigned xb_ld(unsigned* p) { return __hip_atomic_load(p, __ATOMIC_RELAXED, __HIP_MEMORY_SCOPE_AGENT); }
DEV unsigned xb_add(unsigned* p, unsigned v) { return __hip_atomic_fetch_add(p, v, __ATOMIC_RELAXED, __HIP_MEMORY_SCOPE_AGENT); }
DEV unsigned xb_xcc_id() { return (unsigned)__builtin_amdgcn_s_getreg((3 << 11) | 20) & 0xFu; }
#define XB_SPIN(cond, bar) do { unsigned _sp = 0; while (cond) { __builtin_amdgcn_s_sleep(1); \
    if ((++_sp & 255u) == 0u) { if (xb_ld(&(bar)[XB_TMO])) break; if (_sp > XB_SPIN_CAP) { atomicAdd(&(bar)[XB_TMO], 1u); break; } } } } while (0)

struct XcdBarrier { unsigned* bar; unsigned x; volatile unsigned* st; };

DEV void xcd_barrier_complete(unsigned* bar, unsigned x, unsigned& nloc, unsigned& nx) {
  const unsigned G = gridDim.x;
  unsigned sum, cnt, mine, sp = 0u;
  for (;;) {
    sum = 0u; cnt = 0u; mine = 0u;
#pragma unroll
    for (unsigned j = 0; j < 16; ++j) { const unsigned c = xb_ld(&bar[XB_XCNT(j)]); sum += c; cnt += (c > 0u) ? 1u : 0u; mine = (j == x) ? c : mine; }
    if (sum == G) break;
    __builtin_amdgcn_s_sleep(1);
    if ((++sp & 255u) == 0u) { if (xb_ld(&bar[XB_TMO])) break; if (sp > XB_SPIN_CAP) { atomicAdd(&bar[XB_TMO], 1u); break; } }
  }
  nloc = mine > 0u ? mine : 1u; nx = cnt > 0u ? cnt : 1u;
}
DEV void xcd_barrier(const XcdBarrier& b) {
  asm volatile("s_waitcnt vmcnt(0)" ::: "memory");
  __syncthreads();
  if (tid_() == 0) {
    unsigned* bar = b.bar;
    __builtin_amdgcn_s_waitcnt(0);
    unsigned nloc = b.st[0], nx = b.st[1];
    if (nloc == 0u) { xcd_barrier_complete(bar, b.x, nloc, nx); b.st[0] = nloc; b.st[1] = nx; }
    const unsigned old = xb_add(&bar[XB_XSUB(b.x)], 1u);
    const unsigned gen = old / nloc;
    if (old + 1u == (gen + 1u) * nloc) {
      __builtin_amdgcn_fence(__ATOMIC_RELEASE, "agent");
      asm volatile("s_waitcnt vmcnt(0)" ::: "memory");
      const unsigned og = xb_add(&bar[XB_TOP], 1u);
      const unsigned tg = og / nx;
      if (og + 1u == (tg + 1u) * nx) xb_add(&bar[XB_TOPGEN], 1u);
      else XB_SPIN(xb_ld(&bar[XB_TOPGEN]) == tg, bar);
      __builtin_amdgcn_fence(__ATOMIC_ACQUIRE, "agent");
      xb_add(&bar[XB_XGEN(b.x)], 1u);
      asm volatile("s_waitcnt vmcnt(0)" ::: "memory");
    } else {
      XB_SPIN(xb_ld(&bar[XB_XGEN(b.x)]) == gen, bar);
      __builtin_amdgcn_fence(__ATOMIC_ACQUIRE, "agent");
      asm volatile("s_waitcnt vmcnt(0)" ::: "memory");
    }
  }
  __syncthreads();
}
DEV void item_publish(unsigned* ctr) {
  asm volatile("s_waitcnt vmcnt(0)" ::: "memory");
  __syncthreads();
  if (tid_() == 0) {
    __builtin_amdgcn_fence(__ATOMIC_RELEASE, "agent");
    asm volatile("s_waitcnt vmcnt(0)" ::: "memory");
    xb_add(ctr, 1u);
  }
}
DEV void item_wait(unsigned* ctr, unsigned need) {
  if (tid_() == 0) {
    unsigned sp = 0;
    while (xb_ld(ctr) < need) { __builtin_amdgcn_s_sleep(4); if (++sp > (1u << 23)) break; }
    __builtin_amdgcn_fence(__ATOMIC_ACQUIRE, "agent");
    asm volatile("s_waitcnt vmcnt(0)" ::: "memory");
  }
  __syncthreads();
}
DEV int next_item(unsigned* ctr, volatile int* s_item) {
  __syncthreads();
  if (tid_() == 0) *s_item = (int)xb_add(ctr, 1u);
  __syncthreads();
  return *s_item;
}

template <int MAP>
DEV void cvt_tile(GCF src, int N, int k0, int n0, GU dst, int K, char* smem) {
  float* tile = (float*)smem;
  const int tid = tid_();
  float4 v[16];
#pragma unroll
  for (int i = 0; i < 16; ++i) {
    int r = (tid >> 5) + 8 * i, c = (tid & 31) * 4;
    v[i] = make_float4(0.f, 0.f, 0.f, 0.f);
    if (n0 + c < N) v[i] = *(const float4*)(src + (size_t)(k0 + r) * N + n0 + c);
  }
  __syncthreads();
#pragma unroll
  for (int i = 0; i < 16; ++i) {
    int r = (tid >> 5) + 8 * i, c = (tid & 31) * 4;
    tile[r * 129 + c] = v[i].x; tile[r * 129 + c + 1] = v[i].y; tile[r * 129 + c + 2] = v[i].z; tile[r * 129 + c + 3] = v[i].w;
  }
  __syncthreads();
#pragma unroll
  for (int i = 0; i < 8; ++i) {
    int idx = tid + 256 * i, n = idx >> 4, ch = idx & 15;
    unsigned w[4];
#pragma unroll
    for (int j = 0; j < 4; ++j) w[j] = pack2(tile[(ch * 8 + 2 * j) * 129 + n], tile[(ch * 8 + 2 * j + 1) * 129 + n]);
    int nn = n0 + n, drow = nn;
    if (MAP == 1) { int isup = nn >= DFF; int c = nn - isup * DFF; drow = (c >> 6) * 128 + ((c >> 5) & 1) * 64 + isup * 32 + (c & 31); }
    *(uint4*)(dst + (size_t)drow * K + k0 + ch * 8) = make_uint4(w[0], w[1], w[2], w[3]);
  }
}

DEV void mods_tile(const P& p, int item, char* smem) {
  float* sc = (float*)smem;
  float* red = sc + 3 * 1024;
  const int tid = tid_(), l = item / 72, ct = item % 72;
  __syncthreads();
  for (int i = tid; i < 3 * 1024; i += 256) {
    int r = i >> 10, k = i & 1023;
    float c = (r == 0) ? IN(I_CCTX)[k] : IN(I_C)[(r - 1) * 1024 + k];
    sc[i] = siluf_(c);
  }
  __syncthreads();
  const int kq = tid >> 5, c4 = (tid & 31) * 4;
  float acc[3][4];
#pragma unroll
  for (int r = 0; r < 3; ++r)
#pragma unroll
    for (int j = 0; j < 4; ++j) acc[r][j] = 0.f;
  auto w = IN(I_WADA) + ((size_t)l * 1024 + kq * 128) * 9216 + ct * 128 + c4;
#pragma unroll 8
  for (int k = 0; k < 128; ++k) {
    float4 v = *(const float4*)(w + (size_t)k * 9216);
    float s0 = sc[kq * 128 + k], s1 = sc[1024 + kq * 128 + k], s2 = sc[2048 + kq * 128 + k];
    acc[0][0] += s0 * v.x; acc[0][1] += s0 * v.y; acc[0][2] += s0 * v.z; acc[0][3] += s0 * v.w;
    acc[1][0] += s1 * v.x; acc[1][1] += s1 * v.y; acc[1][2] += s1 * v.z; acc[1][3] += s1 * v.w;
    acc[2][0] += s2 * v.x; acc[2][1] += s2 * v.y; acc[2][2] += s2 * v.z; acc[2][3] += s2 * v.w;
  }
#pragma unroll
  for (int r = 0; r < 3; ++r)
#pragma unroll
    for (int j = 0; j < 4; ++j) red[(kq * 3 + r) * 128 + c4 + j] = acc[r][j];
  __syncthreads();
  GF mods = (GF)(p.ws + W_MODS);
  for (int i = tid; i < 3 * 128; i += 256) {
    int r = i >> 7, c = i & 127;
    float s = 0.f;
#pragma unroll
    for (int q = 0; q < 8; ++q) s += red[(q * 3 + r) * 128 + c];
    int col = ct * 128 + c;
    mods[((size_t)l * 3 + r) * 9216 + col] = s + IN(I_BADA)[(size_t)l * 9216 + col];
  }
}

DEV void phase_setup0(const P& p, char* smem) {
  const int n0 = 8 * 352, n1 = 8 * 176, n2 = 4 * 216, n3 = 4 * 64, n4 = 4 * 6, n5 = 4 * 4, n6 = 288, n7 = 1;
  const int n8 = 512, n9 = 2560;
  const int total = n0 + n1 + n2 + n3 + n4 + n5 + n6 + n7 + n8 + n9;
  for (int it = blockIdx.x; it < total; it += gridDim.x) {
    int i = it;
    if (i >= total - n9) {
      int idx = (i - (total - n9)) * 256 + tid_();
      if (idx < 2 * 262144) {
        const int which = idx >> 18, e = idx & 262143, l = e >> 16, n = (e >> 7) & 511, k = e & 127;
        const int d = n >> 8, jc = n & 255;
        float v = 0.f;
        if ((k >> 6) == d) v = IN(which ? I_RA2 : I_RW2)[(((size_t)l * 2 + d) * 64 + (k & 63)) * 256 + jc];
        ((GU)(p.ws + (which ? W_LA : W_LW)))[e] = f2bf(v);
      } else {
        const int e = idx - 2 * 262144, l = e >> 15, n = (e >> 7) & 255, k = e & 127;
        ((GU)(p.ws + W_LG))[e] = f2bf(IN(I_RG2)[((size_t)l * 128 + k) * 256 + n]);
      }
      continue;
    }
    i = it;
    if (i >= total - n9 - n8) i += 0;
    if (i >= total - n9 - n8) {
      int idx = (i - (total - n9 - n8)) * 256 + tid_();
      int t = idx >> 5, ri = idx & 31;
      float pos = (float)((ri < 16) ? (t >> 6) : (t & 63));
      float inv = expf(-(float)(ri & 7) * (9.210340371976184f / 8.f));
      float sn, cs; sincosf(pos * inv, &sn, &cs);
      ((GF)(p.ws + W_ROPE))[idx * 2] = cs; ((GF)(p.ws + W_ROPE))[idx * 2 + 1] = sn;
      continue;
    }
    if (i < n6) { mods_tile(p, i, smem); continue; }
    i -= n6;
    if (i < n0) { int mat = i / 352, t = i % 352; int kt = t / 44, nt = t % 44;
      cvt_tile<1>(IN(I_WFI) + (size_t)mat * 1024 * 5632, 5632, kt * 128, nt * 128, (GU)(p.ws + W_WFI) + (size_t)mat * 5632 * LDH, LDH, smem); continue; }
    i -= n0;
    if (i < n1) { int mat = i / 176, t = i % 176; int kt = t / 8, nt = t % 8;
      cvt_tile<0>(IN(I_WFO) + (size_t)mat * 2816 * 1024, 1024, kt * 128, nt * 128, (GU)(p.ws + W_WFO) + (size_t)mat * 1024 * LDF, LDF, smem); continue; }
    i -= n1;
    if (i < n2) { int mat = i / 216, t = i % 216; int kt = t / 27, nt = t % 27;
      cvt_tile<0>(IN(I_WIN) + (size_t)mat * 1024 * DIN, DIN, kt * 128, nt * 128, (GU)(p.ws + W_WIN) + (size_t)mat * PLD * LDH, LDH, smem); continue; }
    i -= n2;
    if (i < n3) { int mat = i / 64, t = i % 64; int kt = t / 8, nt = t % 8;
      cvt_tile<0>(IN(I_WOUT) + (size_t)mat * 1024 * 1024, 1024, kt * 128, nt * 128, (GU)(p.ws + W_WOUT) + (size_t)mat * 1024 * LDH, LDH, smem); continue; }
    i -= n3;
    if (i < n4) { int mat = i / 6, t = i % 6; int kt = t / 3, nt = t % 3;
      cvt_tile<0>(IN(I_WUQ) + (size_t)mat * 256 * 384, 384, kt * 128, nt * 128, (GU)(p.ws + W_WUQ) + (size_t)mat * 384 * 256, 256, smem); continue; }
    i -= n4;
    if (i < n5) { int mat = i / 4, t = i % 4; int kt = t / 4, nt = t % 4;
      cvt_tile<0>(IN(I_WUKV) + (size_t)mat * 128 * 512, 512, kt * 128, nt * 128, (GU)(p.ws + W_WUKV) + (size_t)mat * 512 * 128, 128, smem); continue; }
    GF lbs = (GF)(p.ws + W_LBS);
    for (int e = tid_(); e < 512; e += 256) {
      float v[4], mx = -1e30f;
#pragma unroll
      for (int l = 0; l < 4; ++l) { v[l] = IN(I_HLB)[l * 512 + e]; mx = fmaxf(mx, v[l]); }
      float s = 0.f;
#pragma unroll
      for (int l = 0; l < 4; ++l) { v[l] = expf(v[l] - mx); s += v[l]; }
      float inv = 1.f / s, cum = 0.f;
#pragma unroll
      for (int l = 0; l < 4; ++l) { cum += v[l] * inv; lbs[l * 512 + e] = cum - v[0] * inv; }
    }
  }
}

DEV void phase_setup1(const P& p) {
  GCF mods = (GCF)(p.ws + W_MODS);
  GF x = (GF)(p.ws + W_X);
  GU h = (GU)(p.ws + W_H);
  const int lane = tid_() & 63, wid = tid_() >> 6;
  for (int m = blockIdx.x * 4 + wid; m < MT_ROWS; m += gridDim.x * 4) {
    auto src = m < MCTX ? IN(I_XP) + (size_t)m * 1024 : IN(I_XS) + (size_t)(m - MCTX) * 1024;
    auto md = mods + (size_t)cond_idx(m) * 9216;
#pragma unroll
    for (int i = 0; i < 4; ++i) {
      int c = lane * 4 + 256 * i;
      float4 v = *(const float4*)(src + c);
      float4 sh = *(const float4*)(md + c), sc = *(const float4*)(md + 1024 + c);
      *(float4*)(x + (size_t)m * 1024 + c) = v;
      uint2 o; o.x = pack2(v.x * (1.f + sc.x) + sh.x, v.y * (1.f + sc.y) + sh.y); o.y = pack2(v.z * (1.f + sc.z) + sh.z, v.w * (1.f + sc.w) + sh.w);
      *(uint2*)(h + (size_t)m * LDH + c) = o;
    }
  }
}

DEV void phase_ln(const P& p, int l, int j, int lm, int mi, bool last) {
  GCF mods = (GCF)(p.ws + W_MODS);
  GF x = (GF)(p.ws + W_X);
  GU h = (GU)(p.ws + W_H);
  auto g = IN(I_LNG) + ((size_t)l * 3 + j) * 1024;
  auto b = IN(I_LNB) + ((size_t)l * 3 + j) * 1024;
  const int lane = tid_() & 63, wid = tid_() >> 6;
  float4 gg4[4], bb4[4];
#pragma unroll
  for (int i = 0; i < 4; ++i) { gg4[i] = *(const float4*)(g + lane * 4 + 256 * i); bb4[i] = *(const float4*)(b + lane * 4 + 256 * i); }
  const int stride = gridDim.x * 4;
  for (int m0r = blockIdx.x * 4 + wid; m0r < MT_ROWS; m0r += 2 * stride) {
    float4 v[2][4], sh4[2][4], sc4[2][4];
#pragma unroll
    for (int rr = 0; rr < 2; ++rr) {
      const int m = m0r + rr * stride;
      if (m < MT_ROWS) {
        auto md = mods + ((size_t)lm * 3 + cond_idx(m)) * 9216 + (size_t)mi * 1024;
#pragma unroll
        for (int i = 0; i < 4; ++i) v[rr][i] = *(const float4*)(x + (size_t)m * 1024 + lane * 4 + 256 * i);
#pragma unroll
        for (int i = 0; i < 4; ++i) { sh4[rr][i] = *(const float4*)(md + lane * 4 + 256 * i); sc4[rr][i] = *(const float4*)(md + 1024 + lane * 4 + 256 * i); }
        if (m >= 8192) {
          GCF xd = (GCF)(p.ws + W_XD) + (size_t)(m - 8192) * 1024;
#pragma unroll
          for (int i = 0; i < 4; ++i) { float4 e = *(const float4*)(xd + lane * 4 + 256 * i); v[rr][i].x += e.x; v[rr][i].y += e.y; v[rr][i].z += e.z; v[rr][i].w += e.w; }
        }
      }
    }
#pragma unroll
    for (int rr = 0; rr < 2; ++rr) {
      const int m = m0r + rr * stride;
      if (m < MT_ROWS) {
        float s = 0.f;
#pragma unroll
        for (int i = 0; i < 4; ++i) s += v[rr][i].x + v[rr][i].y + v[rr][i].z + v[rr][i].w;
        float mu = wave_sum(s) * (1.f / 1024.f);
        float q = 0.f;
#pragma unroll
        for (int i = 0; i < 4; ++i) { float a = v[rr][i].x - mu, bb = v[rr][i].y - mu, c = v[rr][i].z - mu, d = v[rr][i].w - mu; q += a * a + bb * bb + c * c + d * d; }
        float rstd = rsqrtf(wave_sum(q) * (1.f / 1024.f) + 1e-5f);
#pragma unroll
        for (int i = 0; i < 4; ++i) {
          int c = lane * 4 + 256 * i;
          float4 gg = gg4[i], bb = bb4[i];
          float4 o;
          o.x = (v[rr][i].x - mu) * rstd * gg.x + bb.x; o.y = (v[rr][i].y - mu) * rstd * gg.y + bb.y;
          o.z = (v[rr][i].z - mu) * rstd * gg.z + bb.z; o.w = (v[rr][i].w - mu) * rstd * gg.w + bb.w;
          if (last) { *(float4*)(OUTP + O_Y + (size_t)m * 1024 + c) = o; }
          else {
            *(float4*)(x + (size_t)m * 1024 + c) = o;
            float4 sh = sh4[rr][i], sc = sc4[rr][i];
            uint2 w; w.x = pack2(o.x * (1.f + sc.x) + sh.x, o.y * (1.f + sc.y) + sh.y); w.y = pack2(o.z * (1.f + sc.z) + sh.z, o.w * (1.f + sc.w) + sh.w);
            *(uint2*)(h + (size_t)m * LDH + c) = w;
          }
        }
      }
    }
  }
}

enum { EPI_ACT = 0, EPI_RES, EPI_PROJ, EPI_Q, EPI_KV, EPI_LW, EPI_LA, EPI_LG, EPI_RESD };
struct EpiArg { int l; int gidx; float gs; };

template <int EPI>
DEV void gemm_tile(const P& p, GCU A, int lda, GCU Bt, int ldb, int K,
                                       int m0, int n0, EpiArg ea, char* smem) {
  const int tid = tid_(), lane = tid & 63, wid = tid >> 6, wr = wid >> 1, wc = wid & 1, fr = lane & 15, fq = lane >> 4;
  f32x4 acc[4][4];
#pragma unroll
  for (int i = 0; i < 4; ++i)
#pragma unroll
    for (int j = 0; j < 4; ++j) acc[i][j] = (f32x4){0.f, 0.f, 0.f, 0.f};
  const int lrow = tid >> 3, lpos = tid & 7, gch = lpos ^ ((lrow >> 1) & 7);
  GCU Ag = A + (size_t)(m0 + lrow) * lda + gch * 8;
  GCU Bg = Bt + (size_t)(n0 + lrow) * ldb + gch * 8;
  typedef __attribute__((address_space(3))) unsigned* lds_u;
#define G_ISSUE(stage_, koff) do { \
    char* sb_ = smem + (stage_) * 32768 + wid * 1024; \
    _Pragma("unroll") for (int i = 0; i < 4; ++i) { \
      __builtin_amdgcn_global_load_lds((const AS1 unsigned*)(Ag + (size_t)(32 * i) * lda + (koff)), (lds_u)(sb_ + i * 4096), 16, 0, 0); \
      __builtin_amdgcn_global_load_lds((const AS1 unsigned*)(Bg + (size_t)(32 * i) * ldb + (koff)), (lds_u)(sb_ + 16384 + i * 4096), 16, 0, 0); } } while (0)
  const int nk = K >> 6;
  float xpre[EPI == EPI_RES ? 64 : 1], gpre[4];
  if (EPI == EPI_RES) {
    GCF xq = (GCF)(p.ws + W_X) + (size_t)(m0 + wr * 64 + fq * 4) * 1024 + n0 + wc * 64 + fr;
#pragma unroll
    for (int mi = 0; mi < 4; ++mi)
#pragma unroll
      for (int j = 0; j < 4; ++j)
#pragma unroll
        for (int ni = 0; ni < 4; ++ni) xpre[(mi * 4 + j) * 4 + ni] = xq[(size_t)(mi * 16 + j) * 1024 + ni * 16];
    GCF mq = (GCF)(p.ws + W_MODS) + ((size_t)ea.l * 3 + cond_idx(m0)) * 9216 + (size_t)ea.gidx * 1024 + n0 + wc * 64 + fr;
#pragma unroll
    for (int ni = 0; ni < 4; ++ni) gpre[ni] = mq[ni * 16] * ea.gs;
  }
  __syncthreads();
  G_ISSUE(0, 0);
  asm volatile("s_waitcnt vmcnt(0)" ::: "memory");
  __syncthreads();
  const int sw = (fr >> 1) & 7;
  for (int kt = 0; kt < nk; ++kt) {
    const int buf = kt & 1;
    if (kt + 1 < nk) G_ISSUE(buf ^ 1, (kt + 1) * 64);
    const char* as = smem + buf * 32768 + (wr * 64 + fr) * 128;
    const char* bs = smem + buf * 32768 + 16384 + (wc * 64 + fr) * 128;
#pragma unroll
    for (int ks = 0; ks < 2; ++ks) {
      const int co = ((ks * 4 + fq) ^ sw) * 16;
      bf16x8 af[4], bfr[4];
#pragma unroll
      for (int i = 0; i < 4; ++i) { af[i] = *(const bf16x8*)(as + i * 2048 + co); bfr[i] = *(const bf16x8*)(bs + i * 2048 + co); }
      __builtin_amdgcn_s_setprio(1);
#pragma unroll
      for (int i = 0; i < 4; ++i)
#pragma unroll
        for (int j = 0; j < 4; ++j) acc[i][j] = __builtin_amdgcn_mfma_f32_16x16x32_bf16(af[i], bfr[j], acc[i][j], 0, 0, 0);
      __builtin_amdgcn_s_setprio(0);
      __builtin_amdgcn_sched_barrier(0);
    }
    asm volatile("s_waitcnt vmcnt(0)" ::: "memory");
    __syncthreads();
  }
#undef G_ISSUE
  const int rbase = m0 + wr * 64 + fq * 4, cbase = n0 + wc * 64 + fr;
  if (EPI == EPI_ACT) {
    GU act = (GU)(p.ws + W_BIG);
#pragma unroll
    for (int mi = 0; mi < 4; ++mi)
#pragma unroll
      for (int j = 0; j < 4; ++j) {
        int row = rbase + mi * 16 + j;
#pragma unroll
        for (int ni = 0; ni < 2; ++ni) {
          float g = acc[mi][ni][j], u = acc[mi][ni + 2][j];
          act[(size_t)row * LDF + (n0 >> 1) + wc * 32 + ni * 16 + fr] = f2bf(siluf_(g) * u);
        }
        __builtin_amdgcn_sched_barrier(0);
      }
  } else if (EPI == EPI_RES) {
    GF x = (GF)(p.ws + W_X);
#pragma unroll
    for (int mi = 0; mi < 4; ++mi) {
#pragma unroll
      for (int j = 0; j < 4; ++j) {
        auto xr = x + (size_t)(rbase + mi * 16 + j) * 1024 + cbase;
#pragma unroll
        for (int ni = 0; ni < 4; ++ni) xr[ni * 16] = ALPHA * xpre[(mi * 4 + j) * 4 + ni] + gpre[ni] * acc[mi][ni][j];
      }
    }
  } else if (EPI == EPI_RESD) {
    GF xd = (GF)(p.ws + W_XD);
    GCF mods = (GCF)(p.ws + W_MODS);
    auto md = mods + ((size_t)ea.l * 3 + cond_idx(m0)) * 9216 + (size_t)ea.gidx * 1024 + cbase;
    float gate[4];
#pragma unroll
    for (int ni = 0; ni < 4; ++ni) gate[ni] = md[ni * 16] * ea.gs;
#pragma unroll
    for (int mi = 0; mi < 4; ++mi) {
#pragma unroll
      for (int j = 0; j < 4; ++j) {
        auto xr = xd + (size_t)(rbase + mi * 16 + j - 8192) * 1024 + cbase;
#pragma unroll
        for (int ni = 0; ni < 4; ++ni) xr[ni * 16] = gate[ni] * acc[mi][ni][j];
      }
      __builtin_amdgcn_sched_barrier(0);
    }
  } else if (EPI == EPI_PROJ) {
    GF pr = (GF)(p.ws + W_BIG);
#pragma unroll
    for (int mi = 0; mi < 4; ++mi) {
#pragma unroll
      for (int j = 0; j < 4; ++j) {
        auto prr = pr + (size_t)(rbase + mi * 16 + j) * PLD + cbase;
#pragma unroll
        for (int ni = 0; ni < 4; ++ni) prr[ni * 16] = acc[mi][ni][j];
      }
      __builtin_amdgcn_sched_barrier(0);
    }
    if (n0 >= C_AW && n0 < C_AW + 384) {
      GU lin = (GU)(p.ws + W_LIN);
      const int kind = (n0 - C_AW) >> 7;
#pragma unroll
      for (int mi = 0; mi < 4; ++mi)
#pragma unroll
        for (int j = 0; j < 4; ++j)
#pragma unroll
          for (int ni = 0; ni < 4; ++ni) {
            float v = acc[mi][ni][j];
            v = kind == 0 ? tanhf_(v) : (kind == 2 ? sigmoidf_(v) : v);
            lin[(size_t)(rbase + mi * 16 + j) * 384 + (cbase - C_AW) + ni * 16] = f2bf(v);
          }
    }
  } else if (EPI == EPI_LW || EPI == EPI_LA) {
    GF dst = (GF)(p.ws + (EPI == EPI_LW ? W_RWW : W_RWA));
    GCF bias = IN(EPI == EPI_LW ? I_RW0 : I_RA0);
#pragma unroll
    for (int ni = 0; ni < 4; ++ni) {
      const int col = cbase + ni * 16, d = col >> 8, jc = col & 255;
      const float b0 = bias[(ea.l * 2 + d) * 256 + jc];
#pragma unroll
      for (int mi = 0; mi < 4; ++mi)
#pragma unroll
        for (int j = 0; j < 4; ++j) {
          const float a = b0 + acc[mi][ni][j];
          float r;
          if (EPI == EPI_LW) { float wl = -softplusf_(-a) - 0.5f; r = __expf(-__expf(wl)); } else r = sigmoidf_(a);
          dst[((size_t)d * MT_ROWS + rbase + mi * 16 + j) * 256 + jc] = r;
        }
    }
  } else if (EPI == EPI_LG) {
    GF dst = (GF)(p.ws + W_RWG);
#pragma unroll
    for (int mi = 0; mi < 4; ++mi)
#pragma unroll
      for (int j = 0; j < 4; ++j)
#pragma unroll
        for (int ni = 0; ni < 4; ++ni) dst[(size_t)(rbase + mi * 16 + j) * 256 + cbase + ni * 16] = acc[mi][ni][j];
  } else if (EPI == EPI_Q) {
    GU qb = (GU)(p.ws + W_QB);
    const bool latent = m0 >= MCTX;
#pragma unroll
    for (int ni = 0; ni < 4; ++ni) {
      const int col = cbase + ni * 16;
      const int ctile = (n0 + wc * 64 + ni * 16) >> 4;
      const int tin = ctile % 6;
      const bool rope = latent && tin >= 4;
      const int i = (tin - 4) * 16 + fr;
      GCF rtab = (GCF)(p.ws + W_ROPE);
#pragma unroll
      for (int mi = 0; mi < 4; ++mi)
#pragma unroll
        for (int j = 0; j < 4; ++j) {
          const int row = rbase + mi * 16 + j;
          float v = acc[mi][ni][j];
          if (rope) {
            float pv = __shfl_xor(v, 8, 64);
            int t = (row - MCTX) & 4095;
            float cs = rtab[(t * 32 + i) * 2], sn = rtab[(t * 32 + i) * 2 + 1];
            v = (i & 8) ? (v * cs + pv * sn) : (v * cs - pv * sn);
          }
          qb[(size_t)row * 384 + col] = f2bf(v * QSCALE);
        }
    }
  } else if (EPI == EPI_KV) {
    GU kb = (GU)(p.ws + W_KB);
    GU vt = (GU)(p.ws + W_VT);
#pragma unroll
    for (int ni = 0; ni < 4; ++ni) {
      const int col = cbase + ni * 16, head = col >> 7, dd = col & 127;
#pragma unroll
      for (int mi = 0; mi < 4; ++mi) {
        const int row = rbase + mi * 16;
        if (dd < 64) {
#pragma unroll
          for (int j = 0; j < 4; ++j) kb[((size_t)(row + j) * 4 + head) * 96 + dd] = f2bf(acc[mi][ni][j]);
        } else {
          uint2 w; w.x = pack2(acc[mi][ni][0], acc[mi][ni][1]); w.y = pack2(acc[mi][ni][2], acc[mi][ni][3]);
          *(uint2*)(vt + (size_t)(head * 64 + dd - 64) * MKV + row) = w;
        }
      }
    }
  }
}

template <int EPI>
DEV void gemm_phase(const P& p, GCU A, int lda, GCU Bt, int ldb, int K, int MT, int NT, EpiArg ea, char* smem) {
  const int xcd = blockIdx.x & 7, slot = blockIdx.x >> 3, spx = gridDim.x >> 3;
  const int sbM = (MT + 7) >> 3, sbN = (NT + 7) >> 3, nsb = sbM * sbN;
  for (int sb = xcd; sb < nsb; sb += 8) {
    const int sm = sb % sbM, sn = sb / sbM;
    for (int idx = slot; idx < 64; idx += spx) {
      const int mt = sm * 8 + (idx & 7), nt = sn * 8 + (idx >> 3);
      if (mt < MT && nt < NT) gemm_tile<EPI>(p, A, lda, Bt, ldb, K, mt * 128, nt * 128, ea, smem);
    }
  }
}

DEV void gemm_res_phase(const P& p, GCU A, int lda, GCU Bt, int ldb, int K, EpiArg ea, char* smem) {
  const int xcd = blockIdx.x & 7, slot = blockIdx.x >> 3, spx = gridDim.x >> 3;
  for (int idx = slot; idx < 64; idx += spx) gemm_tile<EPI_RES>(p, A, lda, Bt, ldb, K, (xcd * 8 + (idx & 7)) * 128, (idx >> 3) * 128, ea, smem);
  const int sb = 8 + (xcd >> 1), kh = xcd & 1, Kh = K >> 1;
  for (int idx = slot; idx < 64; idx += spx) {
    const int m0 = (sb * 8 + (idx & 7)) * 128, n0 = (idx >> 3) * 128;
    if (kh == 0) gemm_tile<EPI_RES>(p, A, lda, Bt, ldb, Kh, m0, n0, ea, smem);
    else gemm_tile<EPI_RESD>(p, A + Kh, lda, Bt + Kh, ldb, Kh, m0, n0, ea, smem);
  }
}

DEV void rwkv_prep_item(const P& p, int l, int tile, char* smem) {
  GCF proj = (GCF)(p.ws + W_BIG);
  GF rwkk = (GF)(p.ws + W_RWKK);
  const int tid = tid_(), m0 = tile * 32, j = tid;
  const float kkp = IN(I_RKK)[l * 256 + j];
#pragma unroll
  for (int tb = 0; tb < 2; ++tb) {
    float kv[16];
#pragma unroll
    for (int i = 0; i < 16; ++i) kv[i] = proj[(size_t)(m0 + tb * 16 + i) * PLD + C_AK + j] * kkp;
#pragma unroll
    for (int i = 0; i < 16; ++i) {
      float ss = wave_sum(kv[i] * kv[i]);
      rwkk[(size_t)(m0 + tb * 16 + i) * 256 + j] = kv[i] / fmaxf(sqrtf(ss), 1e-12f);
    }
  }
}

DEV void rg_prep_item(const P& p, int l, int tile, char* smem) {
  typedef __attribute__((ext_vector_type(16))) float f32x16;
  float* us = (float*)smem;
  u16* ub = (u16*)(smem + 32768);
  GCF proj = (GCF)(p.ws + W_BIG);
  const int tid = tid_(), m0 = tile * 32, j = tid, g = tid >> 6, lane = tid & 63, l32 = lane & 31, lh = lane >> 5;
  const int s = m0 < MCTX ? (m0 >> 8) : 16 + ((m0 - MCTX) >> 12);
  const int r0 = seq_row0(s), T = seq_len(s);
  {
    const float cw0 = IN(I_CVW)[(l * 4 + 0) * 256 + j], cw1 = IN(I_CVW)[(l * 4 + 1) * 256 + j],
                cw2 = IN(I_CVW)[(l * 4 + 2) * 256 + j], cw3 = IN(I_CVW)[(l * 4 + 3) * 256 + j], cb = IN(I_CVB)[l * 256 + j];
    const int tb = m0 - r0;
    float xv[35];
#pragma unroll
    for (int i = 0; i < 35; ++i) { int t = tb + i - 2; xv[i] = (t >= 0 && t < T) ? proj[(size_t)(r0 + t) * PLD + C_CX + j] : 0.f; }
#pragma unroll
    for (int tok = 0; tok < 32; ++tok) {
      float u = cb + cw0 * xv[tok] + cw1 * xv[tok + 1] + cw2 * xv[tok + 2] + cw3 * xv[tok + 3];
      us[tok * 256 + j] = u; ub[tok * 264 + j] = f2bf(u);
    }
  }
  __syncthreads();
  GF rga = (GF)(p.ws + W_RGA); GF rgb = (GF)(p.ws + W_RGB);
  GF rgta = (GF)(p.ws + W_RGTA); GF rgtb = (GF)(p.ws + W_RGTB);
  bf16x8 af[4];
#pragma unroll
  for (int ks = 0; ks < 4; ++ks) af[ks] = *(const bf16x8*)(ub + l32 * 264 + g * 64 + ks * 16 + lh * 8);
#pragma unroll 1
  for (int dn = 0; dn < 4; ++dn) {
    const int d = dn >> 1, nb = dn & 1;
    f32x16 cr, ci;
#define RG_GATE(WIDX_, D_) do { \
      auto W = IN(WIDX_) + ((size_t)((l * 2 + d) * 4 + g)) * 4096; \
      _Pragma("unroll") for (int r = 0; r < 16; ++r) D_[r] = 0.f; \
      float wv[32]; \
      _Pragma("unroll") for (int ks = 0; ks < 4; ++ks) \
        _Pragma("unroll") for (int jj = 0; jj < 8; ++jj) wv[ks * 8 + jj] = W[(ks * 16 + lh * 8 + jj) * 64 + nb * 32 + l32]; \
      _Pragma("unroll") for (int ks = 0; ks < 4; ++ks) { \
        uint4 pw = make_uint4(pack2(wv[ks * 8 + 0], wv[ks * 8 + 1]), pack2(wv[ks * 8 + 2], wv[ks * 8 + 3]), pack2(wv[ks * 8 + 4], wv[ks * 8 + 5]), pack2(wv[ks * 8 + 6], wv[ks * 8 + 7])); \
        bf16x8 bfr = __builtin_bit_cast(bf16x8, pw); \
        D_ = __builtin_amdgcn_mfma_f32_32x32x16_bf16(af[ks], bfr, D_, 0, 0, 0); \
      } } while (0)
    RG_GATE(I_GWA, cr);
    RG_GATE(I_GWX, ci);
#undef RG_GATE
    {
      const int ch = g * 64 + nb * 32 + l32;
      const float ba = IN(I_GBA)[(l * 2 + d) * 256 + ch], bx = IN(I_GBX)[(l * 2 + d) * 256 + ch];
      const float spl = softplusf_(-IN(I_GLAM)[(l * 2 + d) * 256 + ch]);
      float sA[4], sB[4];
#pragma unroll
      for (int q = 0; q < 4; ++q) {
        float cA = 1.f, cB = 0.f;
#pragma unroll
        for (int rr = 0; rr < 4; ++rr) {
          const int r = q * 4 + rr, tok = 8 * q + 4 * lh + rr;
          const float rg = sigmoidf_(cr[r] + ba), ig = sigmoidf_(ci[r] + bx);
          const float la = -8.f * rg * spl;
          const float av = __expf(la);
          const float bv = sqrtf(fmaxf(1.f - av * av, 0.f)) * (ig * us[tok * 256 + ch]);
          rga[((size_t)d * MT_ROWS + m0 + tok) * 256 + ch] = av;
          rgb[((size_t)d * MT_ROWS + m0 + tok) * 256 + ch] = bv;
          if (d == 0) { cB = cB * av + bv; cA = cA * av; } else { cB = cB + cA * bv; cA = cA * av; }
        }
        sA[q] = cA; sB[q] = cB;
      }
      float oA[4], oB[4];
#pragma unroll
      for (int q = 0; q < 4; ++q) { oA[q] = __shfl_xor(sA[q], 32, 64); oB[q] = __shfl_xor(sB[q], 32, 64); }
      float cA = 1.f, cB = 0.f;
#pragma unroll
      for (int q8 = 0; q8 < 8; ++q8) {
        const bool mine = (q8 & 1) == lh;
        const float a_ = mine ? sA[q8 >> 1] : oA[q8 >> 1], b_ = mine ? sB[q8 >> 1] : oB[q8 >> 1];
        if (d == 0) { cB = cB * a_ + b_; cA = cA * a_; } else { cB = cB + cA * b_; cA = cA * a_; }
      }
      if (lh == 0) { rgta[((size_t)d * 384 + tile) * 256 + ch] = cA; rgtb[((size_t)d * 384 + tile) * 256 + ch] = cB; }
    }
  }
}

DEV void mla_prep_item(const P& p, int l, int item) {
  GCF proj = (GCF)(p.ws + W_BIG);
  GU cqn = (GU)(p.ws + W_CQN); GU ckvn = (GU)(p.ws + W_CKVN); GU kb = (GU)(p.ws + W_KB);
  const int lane = tid_() & 63, wid = tid_() >> 6;
  for (int r = 0; r < 16; ++r) {
    const int m = item * 64 + wid * 16 + r;
    if (m < MT_ROWS) {
      auto pr = proj + (size_t)m * PLD;
      float4 q = *(const float4*)(pr + C_BQ + lane * 4);
      float ss = wave_sum(q.x * q.x + q.y * q.y + q.z * q.z + q.w * q.w);
      float rs = rsqrtf(ss * (1.f / 256.f) + 1e-6f);
      float4 g = *(const float4*)(IN(I_QNG) + l * 256 + lane * 4);
      uint2 w; w.x = pack2(q.x * rs * g.x, q.y * rs * g.y); w.y = pack2(q.z * rs * g.z, q.w * rs * g.w);
      *(uint2*)(cqn + (size_t)m * 256 + lane * 4) = w;
      float2 c = *(const float2*)(pr + C_BKV + lane * 2);
      float s2 = wave_sum(c.x * c.x + c.y * c.y);
      float r2 = rsqrtf(s2 * (1.f / 128.f) + 1e-6f);
      float2 g2 = *(const float2*)(IN(I_KVNG) + l * 128 + lane * 2);
      float c0 = c.x * r2 * g2.x, c1 = c.y * r2 * g2.y;
      *(unsigned*)(ckvn + (size_t)m * 128 + lane * 2) = pack2(c0, c1);
      float pe = pr[C_BPE + (lane & 31)];
      float ppe = __shfl_xor(pe, 8, 64);
      float kv = pe;
      if (m < MCTX) {
        int b = m >> 8, t = m & 255;
        *(float2*)(OUTP + O_CKV + (((size_t)b * 4 + l) * 256 + t) * 128 + lane * 2) = make_float2(c0, c1);
        if (lane < 32) OUTP[O_KPE + (((size_t)b * 4 + l) * 256 + t) * 32 + lane] = pe;
      } else {
        int i = lane & 31, t = (m - MCTX) & 4095;
        float cs = ((GCF)(p.ws + W_ROPE))[(t * 32 + i) * 2], sn = ((GCF)(p.ws + W_ROPE))[(t * 32 + i) * 2 + 1];
        kv = (i & 8) ? (pe * cs + ppe * sn) : (pe * cs - ppe * sn);
      }
      if (lane < 32) {
        u16 kb16 = f2bf(kv);
#pragma unroll
        for (int hh = 0; hh < 4; ++hh) kb[((size_t)m * 4 + hh) * 96 + 64 + lane] = kb16;
      }
    } else {
      const int cr = m - MT_ROWS, b = cr >> 9, pp = cr & 511;
      float2 c = *(const float2*)(IN(I_CCKV) + (((size_t)b * 4 + l) * 512 + pp) * 128 + lane * 2);
      *(unsigned*)(ckvn + (size_t)m * 128 + lane * 2) = pack2(c.x, c.y);
      if (lane < 32) {
        u16 kb16 = f2bf(IN(I_CKPE)[(((size_t)b * 4 + l) * 512 + pp) * 32 + lane]);
#pragma unroll
        for (int hh = 0; hh < 4; ++hh) kb[((size_t)m * 4 + hh) * 96 + 64 + lane] = kb16;
      }
    }
  }
}

DEV void hg_decode(int item, int& s, int& c, int& d, int& h) {
  h = item & 3; d = (item >> 2) & 1; int ch = item >> 3;
  if (ch < 64) { s = ch >> 2; c = ch & 3; } else { s = 16 + ((ch - 64) >> 6); c = (ch - 64) & 63; }
}
template <bool WITHQ, int N>
DEV void hg_stage(const P& p, int l, int s, int d, int h, int i0, float* gs, float* vs, float* qs) {
  GCF proj = (GCF)(p.ws + W_BIG);
  GCF lbs = (GCF)(p.ws + W_LBS) + (l * 2 + d) * 256 + h * 64;
  const int r0 = seq_row0(s), T = seq_len(s), tid = tid_();
  const int k = tid & 63;
  const float lb = lbs[k];
  constexpr int NI = N / 4;
  float xf[NI], xv[NI], xq[NI];
#pragma unroll
  for (int u = 0; u < NI; ++u) {
    int i = (tid >> 6) + 4 * u;
    int t = d ? (T - 1 - (i0 + i)) : (i0 + i);
    auto pr = proj + (size_t)(r0 + t) * PLD;
    xf[u] = pr[C_DF + d * 256 + h * 64 + k]; xv[u] = pr[C_DI + h * 64 + k];
    if (WITHQ) xq[u] = pr[C_DQ + h * 64 + k];
  }
#pragma unroll
  for (int u = 0; u < NI; ++u) {
    int idx = ((tid >> 6) + 4 * u) * 64 + k;
    gs[idx] = lb + (1.f - lb) * sigmoidf_(xf[u]);
    vs[idx] = xv[u];
    if (WITHQ) qs[idx] = siluf_(xq[u]);
  }
}
DEV void hgrn_a_item(const P& p, int l, int item, char* smem) {
  typedef __attribute__((ext_vector_type(16))) float f32x16;
  float* gs = (float*)smem; float* vs = gs + 4096;
  float* part = vs + 4096;
  u16* wT = (u16*)(part + 256);
  u16* vT = wT + 64 * 72;
  int s, c, d, h; hg_decode(item, s, c, d, h);
  hg_stage<false, 64>(p, l, s, d, h, c * 64, gs, vs, nullptr);
  __syncthreads();
  const int tid = tid_(), k = tid & 63, qt = tid >> 6, lane = tid & 63, l32 = lane & 31, lh = lane >> 5;
  float lg[16], gk[16], loc = 0.f;
  unsigned vp[8];
#pragma unroll
  for (int u = 0; u < 16; ++u) { gk[u] = gs[(qt * 16 + u) * 64 + k]; lg[u] = __logf(fmaxf(gk[u], 1e-30f)); loc += lg[u]; }
#pragma unroll
  for (int u = 0; u < 8; ++u) vp[u] = pack2(vs[(qt * 16 + 2 * u) * 64 + k], vs[(qt * 16 + 2 * u + 1) * 64 + k]);
  part[qt * 64 + k] = loc;
  *(uint4*)(vT + k * 72 + qt * 16) = make_uint4(vp[0], vp[1], vp[2], vp[3]);
  *(uint4*)(vT + k * 72 + qt * 16 + 8) = make_uint4(vp[4], vp[5], vp[6], vp[7]);
  __syncthreads();
  float pre = 0.f, tot = 0.f;
#pragma unroll
  for (int q = 0; q < 4; ++q) { const float pv = part[q * 64 + k]; if (q < qt) pre += pv; tot += pv; }
  float run = pre;
  unsigned wp[8];
#pragma unroll
  for (int u = 0; u < 8; ++u) {
    run += lg[2 * u]; const float w0 = (1.f - gk[2 * u]) * __expf(tot - run);
    run += lg[2 * u + 1]; const float w1 = (1.f - gk[2 * u + 1]) * __expf(tot - run);
    wp[u] = pack2(w0, w1);
  }
  *(uint4*)(wT + k * 72 + qt * 16) = make_uint4(wp[0], wp[1], wp[2], wp[3]);
  *(uint4*)(wT + k * 72 + qt * 16 + 8) = make_uint4(wp[4], wp[5], wp[6], wp[7]);
  GF hS = (GF)(p.ws + W_HGS) + (size_t)item * 4096;
  GF hD = (GF)(p.ws + W_HGD) + (size_t)item * 64;
  if (qt == 0) hD[k] = __expf(tot);
  __syncthreads();
  const int kb = qt >> 1, vb = qt & 1;
  f32x16 acc;
#pragma unroll
  for (int r = 0; r < 16; ++r) acc[r] = 0.f;
#pragma unroll
  for (int ks = 0; ks < 4; ++ks) {
    const bf16x8 af = *(const bf16x8*)(wT + (kb * 32 + l32) * 72 + ks * 16 + lh * 8);
    const bf16x8 bfr = *(const bf16x8*)(vT + (vb * 32 + l32) * 72 + ks * 16 + lh * 8);
    acc = __builtin_amdgcn_mfma_f32_32x32x16_bf16(af, bfr, acc, 0, 0, 0);
  }
#pragma unroll
  for (int r = 0; r < 16; ++r) hS[(kb * 32 + (r & 3) + 8 * (r >> 2) + 4 * lh) * 64 + vb * 32 + l32] = acc[r];
}
DEV void hgrn_b_item(const P& p, int l, int item) {
  GF hS = (GF)(p.ws + W_HGS); GCF hD = (GCF)(p.ws + W_HGD);
  if (item < 128) {
    const int combo = item, s = combo >> 3, d = (combo >> 2) & 1, h = combo & 3, ch0 = s * 4;
#pragma unroll 1
    for (int ub = 0; ub < 4; ++ub) {
      float t[4][4], dd[4][4];
#pragma unroll
      for (int uu = 0; uu < 4; ++uu) {
        const int e = (ub * 4 + uu) * 256 + tid_();
#pragma unroll
        for (int u = 0; u < 4; ++u) { int it = ((ch0 + u) * 2 + d) * 4 + h; t[uu][u] = hS[(size_t)it * 4096 + e]; dd[uu][u] = hD[(size_t)it * 64 + (e >> 6)]; }
      }
#pragma unroll
      for (int uu = 0; uu < 4; ++uu) {
        const int e = (ub * 4 + uu) * 256 + tid_();
        float S = 0.f;
#pragma unroll
        for (int u = 0; u < 4; ++u) { int it = ((ch0 + u) * 2 + d) * 4 + h; hS[(size_t)it * 4096 + e] = S; S = dd[uu][u] * S + t[uu][u]; }
        OUTP[O_HGRN + ((((size_t)s * 4 + l) * 2 + d) * 4 + h) * 4096 + e] = S;
      }
    }
  } else {
    const int li = item - 128, combo = 128 + (li >> 4), e = (li & 15) * 256 + tid_();
    const int s = combo >> 3, d = (combo >> 2) & 1, h = combo & 3, ch0 = 64 + (s - 16) * 64, k = e >> 6;
    float S = IN(I_SHG)[((((size_t)(s - 16) * 4 + l) * 2 + d) * 4 + h) * 4096 + e];
    for (int c = 0; c < 64; c += 16) {
      float t[16], dd[16];
#pragma unroll
      for (int u = 0; u < 16; ++u) { int it = ((ch0 + c + u) * 2 + d) * 4 + h; t[u] = hS[(size_t)it * 4096 + e]; dd[u] = hD[(size_t)it * 64 + k]; }
#pragma unroll
      for (int u = 0; u < 16; ++u) { int it = ((ch0 + c + u) * 2 + d) * 4 + h; hS[(size_t)it * 4096 + e] = S; S = dd[u] * S + t[u]; }
    }
  }
}
DEV void hgrn_c_item(const P& p, int l, int item, char* smem) {
  float* gs = (float*)smem; float* vs = gs + 2048; float* qs = vs + 2048; float* part = qs + 2048;
  int s, c, d, h; hg_decode(item, s, c, d, h);
  const int tid = tid_(), v = tid & 63, kg = tid >> 6;
  GCF hS = (GCF)(p.ws + W_HGS2) + (size_t)item * 4096;
  GF hgo = (GF)(p.ws + W_HGO);
  const int r0 = seq_row0(s), T = seq_len(s);
  f2_ S[8];
#pragma unroll
  for (int j = 0; j < 8; ++j) { S[j].x = hS[(kg * 16 + 2 * j) * 64 + v]; S[j].y = hS[(kg * 16 + 2 * j + 1) * 64 + v]; }
  for (int half = 0; half < 2; ++half) {
    __syncthreads();
    hg_stage<true, 32>(p, l, s, d, h, c * 64 + half * 32, gs, vs, qs);
    __syncthreads();
#pragma unroll 4
    for (int i = 0; i < 32; ++i) {
      const float vv = vs[i * 64 + v];
      const f2_ vv2 = {vv, vv};
      f2_ o2 = {0.f, 0.f};
#pragma unroll
      for (int j4 = 0; j4 < 4; ++j4) {
        float4 g4 = *(const float4*)(gs + i * 64 + kg * 16 + j4 * 4);
        float4 q4 = *(const float4*)(qs + i * 64 + kg * 16 + j4 * 4);
        const f2_ ga = {g4.x, g4.y}, gb = {g4.z, g4.w}, qa = {q4.x, q4.y}, qb_ = {q4.z, q4.w};
        S[j4 * 2] = ga * (S[j4 * 2] - vv2) + vv2; o2 += qa * S[j4 * 2];
        S[j4 * 2 + 1] = gb * (S[j4 * 2 + 1] - vv2) + vv2; o2 += qb_ * S[j4 * 2 + 1];
      }
      part[(i * 4 + kg) * 64 + v] = o2.x + o2.y;
    }
    __syncthreads();
#pragma unroll
    for (int r = 0; r < 8; ++r) {
      int i = (tid >> 6) + 4 * r;
      float o = part[(i * 4 + 0) * 64 + v] + part[(i * 4 + 1) * 64 + v] + part[(i * 4 + 2) * 64 + v] + part[(i * 4 + 3) * 64 + v];
      int fi = c * 64 + half * 32 + i;
      int t = d ? (T - 1 - fi) : fi;
      hgo[((size_t)d * MT_ROWS + r0 + t) * 256 + h * 64 + v] = o;
    }
  }
}

DEV float geluf_(float x) { return 0.5f * x * (1.f + tanhf(0.7978845608028654f * (x + 0.044715f * x * x * x))); }
DEV void rg_scan_item(const P& p, int l, int tile, char* smem) {
  float* hf = (float*)smem;
  GCF proj = (GCF)(p.ws + W_BIG);
  GCF rga = (GCF)(p.ws + W_RGA); GCF rgb = (GCF)(p.ws + W_RGB);
  GCF rgta = (GCF)(p.ws + W_RGTA); GCF rgtb = (GCF)(p.ws + W_RGTB);
  GU mix = (GU)(p.ws + W_MIX);
  const int j = tid_(), m0 = tile * 32;
  const int s = m0 < MCTX ? (m0 >> 8) : 16 + ((m0 - MCTX) >> 12);
  const int t0 = seq_row0(s) >> 5, nt = seq_len(s) >> 5;
  float h = 0.f;
  if (s >= 16) h = IN(I_SRG)[(((size_t)(s - 16) * 4 + l) * 2 + 0) * 256 + j];
  {
    int tq = t0;
    for (; tq + 16 <= tile; tq += 16) {
      float ca[16], cb_[16];
#pragma unroll
      for (int u = 0; u < 16; ++u) { ca[u] = rgta[(size_t)(tq + u) * 256 + j]; cb_[u] = rgtb[(size_t)(tq + u) * 256 + j]; }
#pragma unroll
      for (int u = 0; u < 16; ++u) h = ca[u] * h + cb_[u];
    }
    for (; tq + 4 <= tile; tq += 4) {
      float ca[4], cb_[4];
#pragma unroll
      for (int u = 0; u < 4; ++u) { ca[u] = rgta[(size_t)(tq + u) * 256 + j]; cb_[u] = rgtb[(size_t)(tq + u) * 256 + j]; }
#pragma unroll
      for (int u = 0; u < 4; ++u) h = ca[u] * h + cb_[u];
    }
    for (; tq < tile; ++tq) h = rgta[(size_t)tq * 256 + j] * h + rgtb[(size_t)tq * 256 + j];
  }
  {
    float av[32], bv[32];
#pragma unroll
    for (int tok = 0; tok < 32; ++tok) { size_t o = (size_t)(m0 + tok) * 256 + j; av[tok] = rga[o]; bv[tok] = rgb[o]; }
#pragma unroll
    for (int tok = 0; tok < 32; ++tok) { h = av[tok] * h + bv[tok]; hf[tok * 256 + j] = h; }
  }
  if (s < 16 && tile == t0 + nt - 1) OUTP[O_RGLRU + (((size_t)s * 4 + l) * 2 + 0) * 256 + j] = h;
  h = 0.f;
  if (s >= 16) h = IN(I_SRG)[(((size_t)(s - 16) * 4 + l) * 2 + 1) * 256 + j];
  {
    int tq = t0 + nt - 1;
    for (; tq - 16 >= tile; tq -= 16) {
      float ca[16], cb_[16];
#pragma unroll
      for (int u = 0; u < 16; ++u) { ca[u] = rgta[((size_t)384 + tq - u) * 256 + j]; cb_[u] = rgtb[((size_t)384 + tq - u) * 256 + j]; }
#pragma unroll
      for (int u = 0; u < 16; ++u) h = ca[u] * h + cb_[u];
    }
    for (; tq - 4 >= tile; tq -= 4) {
      float ca[4], cb_[4];
#pragma unroll
      for (int u = 0; u < 4; ++u) { ca[u] = rgta[((size_t)384 + tq - u) * 256 + j]; cb_[u] = rgtb[((size_t)384 + tq - u) * 256 + j]; }
#pragma unroll
      for (int u = 0; u < 4; ++u) h = ca[u] * h + cb_[u];
    }
    for (; tq > tile; --tq) h = rgta[((size_t)384 + tq) * 256 + j] * h + rgtb[((size_t)384 + tq) * 256 + j];
  }
  {
    float av[32], bv[32], gt[32];
#pragma unroll
    for (int tok = 0; tok < 32; ++tok) { size_t o = ((size_t)MT_ROWS + m0 + tok) * 256 + j; av[tok] = rga[o]; bv[tok] = rgb[o]; gt[tok] = proj[(size_t)(m0 + tok) * PLD + C_CG + j]; }
#pragma unroll
    for (int tok = 31; tok >= 0; --tok) {
      h = av[tok] * h + bv[tok];
      mix[(size_t)(m0 + tok) * LDH + 512 + j] = f2bf((hf[tok * 256 + j] + h) * geluf_(gt[tok]));
    }
  }
  if (s < 16 && tile == t0) OUTP[O_RGLRU + (((size_t)s * 4 + l) * 2 + 1) * 256 + j] = h;
}

DEV void rwkv_scan_item(const P& p, int l, int s, int d, int h, int c, int nch, int g, char* smem) {
  float* buf = (float*)smem;
  float* opart = buf + 2 * 6144;
  GCF proj = (GCF)(p.ws + W_BIG);
  GCF rww = (GCF)(p.ws + W_RWW) + (size_t)d * MT_ROWS * 256;
  GCF rwa = (GCF)(p.ws + W_RWA) + (size_t)d * MT_ROWS * 256;
  GCF rwkk = (GCF)(p.ws + W_RWKK);
  const int tid = tid_(), lane = tid & 63, wid = tid >> 6, e = lane & 15;
  const bool isP = g >= 4;
  const int rowbase = (g & 3) * 16, rl = wid * 4 + (lane >> 4), row = rowbase + rl;
  const int r0 = seq_row0(s), T = seq_len(s), CL = T / nch, nck = CL >> 4, i0 = c * CL;
  auto outp = isP ? (GF)(p.ws + W_RWU) + ((size_t)d * 8192 - MCTX) * 256 : (GF)(p.ws + W_RWO) + (size_t)d * MT_ROWS * 256;
  const int lstep = tid >> 4, lq = (tid & 15) * 4, col = h * 64 + lq;
  const float4 ka4 = *(const float4*)(IN(I_RKA) + l * 256 + col);
  f2_ S01 = {0.f, 0.f}, S23 = {0.f, 0.f};
  if (isP) { S01.x = (e * 4 + 0 == row) ? 1.f : 0.f; S01.y = (e * 4 + 1 == row) ? 1.f : 0.f; S23.x = (e * 4 + 2 == row) ? 1.f : 0.f; S23.y = (e * 4 + 3 == row) ? 1.f : 0.f; }
  else if (c == 0 && s >= 16) {
    float4 st = *(const float4*)(IN(I_SRWKV) + ((((size_t)(s - 16) * 4 + l) * 2 + d) * 4 + h) * 4096 + row * 64 + e * 4);
    S01.x = st.x; S01.y = st.y; S23.x = st.z; S23.y = st.w;
  }
  const float vmask = isP ? 0.f : 1.f;
  float4 gr, gk, gv, gw, ga, gkk;
  auto gload = [&](int ck) {
    int ti = i0 + ck * 16 + lstep; int t = d ? (T - 1 - ti) : ti; size_t m = (size_t)(r0 + t);
    gr = *(const float4*)(proj + m * PLD + C_AR + col); gk = *(const float4*)(proj + m * PLD + C_AK + col); gv = *(const float4*)(proj + m * PLD + C_AV + col);
    gw = *(const float4*)(rww + m * 256 + col); ga = *(const float4*)(rwa + m * 256 + col); gkk = *(const float4*)(rwkk + m * 256 + col);
  };
  auto sstore = [&](int b) {
    float* bb = buf + b * 6144 + lstep * 64 + lq;
    float4 kd, kka;
    kd.x = gk.x * (1.f + (ga.x - 1.f) * ka4.x); kd.y = gk.y * (1.f + (ga.y - 1.f) * ka4.y); kd.z = gk.z * (1.f + (ga.z - 1.f) * ka4.z); kd.w = gk.w * (1.f + (ga.w - 1.f) * ka4.w);
    kka.x = gkk.x * ga.x; kka.y = gkk.y * ga.y; kka.z = gkk.z * ga.z; kka.w = gkk.w * ga.w;
    *(float4*)(bb) = gr; *(float4*)(bb + 1024) = gw; *(float4*)(bb + 2048) = kd; *(float4*)(bb + 3072) = gkk; *(float4*)(bb + 4096) = kka; *(float4*)(bb + 5120) = gv;
  };
  __syncthreads();
  gload(0); sstore(0);
  __syncthreads();
  __builtin_amdgcn_s_setprio(2);
  for (int ck = 0; ck < nck; ++ck) {
    const int b = ck & 1;
    if (ck + 1 < nck) gload(ck + 1);
    const float* bb = buf + b * 6144 + e * 4;
    const float* bv = buf + b * 6144 + 5120 + row;
    float4 r4 = *(const float4*)(bb), w4 = *(const float4*)(bb + 1024), kd4 = *(const float4*)(bb + 2048), kk4 = *(const float4*)(bb + 3072), ka_ = *(const float4*)(bb + 4096);
    float vv = bv[0];
#pragma unroll
    for (int st = 0; st < 16; ++st) {
      float4 nr4, nw4, nkd4, nkk4, nka_; float nvv;
      if (st < 15) {
        nr4 = *(const float4*)(bb + (st + 1) * 64); nw4 = *(const float4*)(bb + 1024 + (st + 1) * 64); nkd4 = *(const float4*)(bb + 2048 + (st + 1) * 64);
        nkk4 = *(const float4*)(bb + 3072 + (st + 1) * 64); nka_ = *(const float4*)(bb + 4096 + (st + 1) * 64); nvv = bv[(st + 1) * 64];
      }
      const float vm = vv * vmask;
      const f2_ kk01 = {kk4.x, kk4.y}, kk23 = {kk4.z, kk4.w}, w01 = {w4.x, w4.y}, w23 = {w4.z, w4.w};
      const f2_ kd01 = {kd4.x, kd4.y}, kd23 = {kd4.z, kd4.w}, ka01 = {ka_.x, ka_.y}, ka23 = {ka_.z, ka_.w}, r01 = {r4.x, r4.y}, r23 = {r4.z, r4.w};
      f2_ dp = S01 * kk01 + S23 * kk23;
      const f2_ vm2 = {vm, vm};
      f2_ t01 = S01 * w01 + vm2 * kd01, t23 = S23 * w23 + vm2 * kd23;
      float pp = row16_sum(dp.x + dp.y);
      const f2_ pp2 = {pp, pp};
      S01 = t01 - pp2 * ka01; S23 = t23 - pp2 * ka23;
      f2_ od = S01 * r01 + S23 * r23;
      opart[(st * 16 + rl) * 16 + e] = od.x + od.y;
      if (st < 15) { r4 = nr4; w4 = nw4; kd4 = nkd4; kk4 = nkk4; ka_ = nka_; vv = nvv; }
    }
    {
      const int ost = lane >> 2, orr = lane & 3;
      const float* op = opart + ((ost * 16 + wid * 4 + orr) * 16);
      float4 a0 = *(const float4*)(op), a1 = *(const float4*)(op + 4), a2 = *(const float4*)(op + 8), a3 = *(const float4*)(op + 12);
      float o = ((a0.x + a0.y) + (a0.z + a0.w)) + ((a1.x + a1.y) + (a1.z + a1.w)) + ((a2.x + a2.y) + (a2.z + a2.w)) + ((a3.x + a3.y) + (a3.z + a3.w));
      int ti = i0 + ck * 16 + ost; int t = d ? (T - 1 - ti) : ti;
      outp[(size_t)(r0 + t) * 256 + h * 64 + rowbase + wid * 4 + orr] = o;
    }
    if (ck + 1 < nck) sstore(b ^ 1);
    __syncthreads();
  }
  __builtin_amdgcn_s_setprio(0);
  const float4 Sf = make_float4(S01.x, S01.y, S23.x, S23.y);
  if (s < 16) *(float4*)(OUTP + O_RWKV + ((((size_t)s * 4 + l) * 2 + d) * 4 + h) * 4096 + row * 64 + e * 4) = Sf;
  else if (c + 1 < nch) {
    const int combo = ((s - 16) * 2 + d) * 4 + h;
    *(float4*)((GF)(p.ws + W_RWE) + (((size_t)combo * 4 + c) * 128 + (isP ? 64 : 0) + row) * 64 + e * 4) = Sf;
  }
}

DEV void rwkv_fix_item(const P& p, int l, int item, char* smem) {
  float* Sc = (float*)smem;
  float* Sn = Sc + 4160;
  float* us = Sn + 4160;
  const int combo = item / 24, rem = item % 24, c = 1 + rem / 8, sub = rem & 7;
  const int b = combo >> 3, d = (combo >> 2) & 1, h = combo & 3;
  GCF E = (GCF)(p.ws + W_RWE) + (size_t)combo * 4 * 8192;
  const int tid = tid_();
  __syncthreads();
  for (int i = tid; i < 4096; i += 256) Sc[(i >> 6) * 65 + (i & 63)] = E[i];
  __syncthreads();
  for (int cc = 1; cc < c; ++cc) {
    auto Es = E + (size_t)cc * 8192; auto Epg = Es + 4096;
    const int r = tid >> 2, jq = (tid & 3) * 16;
    float acc[16];
    {
      float4 pl0 = *(const float4*)(Epg + tid * 4), pl1 = *(const float4*)(Epg + 1024 + tid * 4), pl2 = *(const float4*)(Epg + 2048 + tid * 4), pl3 = *(const float4*)(Epg + 3072 + tid * 4);
#pragma unroll
      for (int j = 0; j < 16; ++j) acc[j] = Es[r * 64 + jq + j];
      *(float4*)(us + tid * 4) = pl0; *(float4*)(us + 1024 + tid * 4) = pl1; *(float4*)(us + 2048 + tid * 4) = pl2; *(float4*)(us + 3072 + tid * 4) = pl3;
    }
    __syncthreads();
    const float* Ep = us;
#pragma unroll 4
    for (int k = 0; k < 64; ++k) {
      const float sv = Sc[r * 65 + k];
      const float4 p0 = *(const float4*)(Ep + k * 64 + jq), p1 = *(const float4*)(Ep + k * 64 + jq + 4), p2 = *(const float4*)(Ep + k * 64 + jq + 8), p3 = *(const float4*)(Ep + k * 64 + jq + 12);
      acc[0] += sv * p0.x; acc[1] += sv * p0.y; acc[2] += sv * p0.z; acc[3] += sv * p0.w;
      acc[4] += sv * p1.x; acc[5] += sv * p1.y; acc[6] += sv * p1.z; acc[7] += sv * p1.w;
      acc[8] += sv * p2.x; acc[9] += sv * p2.y; acc[10] += sv * p2.z; acc[11] += sv * p2.w;
      acc[12] += sv * p3.x; acc[13] += sv * p3.y; acc[14] += sv * p3.z; acc[15] += sv * p3.w;
    }
#pragma unroll
    for (int j = 0; j < 16; ++j) Sn[r * 65 + jq + j] = acc[j];
    __syncthreads();
    for (int i = tid; i < 4160; i += 256) Sc[i] = Sn[i];
    __syncthreads();
  }
  const int T = 4096, CL = 1024, r0 = MCTX + b * 4096;
  GCF rwu = (GCF)(p.ws + W_RWU) + ((size_t)d * 8192 - MCTX) * 256;
  GF rwo = (GF)(p.ws + W_RWO) + (size_t)d * MT_ROWS * 256;
  const int ibase = c * CL + sub * 128;
  {
    float4 ub[8];
#pragma unroll
    for (int u = 0; u < 8; ++u) {
      int i = tid + 256 * u; int st = i >> 4, q4 = (i & 15) * 4;
      int ti = ibase + st; int t = d ? (T - 1 - ti) : ti;
      ub[u] = *(const float4*)(rwu + (size_t)(r0 + t) * 256 + h * 64 + q4);
    }
#pragma unroll
    for (int u = 0; u < 8; ++u) { int i = tid + 256 * u; *(float4*)(us + (i >> 4) * 64 + (i & 15) * 4) = ub[u]; }
  }
  __syncthreads();
  const int row = tid & 63, sg = tid >> 6;
  float srow[64];
#pragma unroll
  for (int k = 0; k < 64; ++k) srow[k] = Sc[row * 65 + k];
  for (int st = sg * 32; st < sg * 32 + 32; ++st) {
    const float* up = us + st * 64;
    float a = 0.f;
#pragma unroll
    for (int k4 = 0; k4 < 16; ++k4) { float4 u = *(const float4*)(up + k4 * 4); a += srow[k4 * 4] * u.x + srow[k4 * 4 + 1] * u.y + srow[k4 * 4 + 2] * u.z + srow[k4 * 4 + 3] * u.w; }
    int ti = ibase + st; int t = d ? (T - 1 - ti) : ti;
    auto o = rwo + (size_t)(r0 + t) * 256 + h * 64 + row;
    *o += a;
  }
}

DEV void attn_item(const P& p, int item, char* smem) {
  GCU qb = (GCU)(p.ws + W_QB); GCU kb = (GCU)(p.ws + W_KB); GCU vt = (GCU)(p.ws + W_VT);
  GU mix = (GU)(p.ws + W_MIX);
  constexpr int KS = 104, VS = 72;
  constexpr int STG = 64 * KS + 64 * VS;
  u16* lds = (u16*)smem;
  const int tid = tid_(), lane = tid & 63, wid = tid >> 6, fr = lane & 15, fq = lane >> 4;
  int h, qrow0, nkt, kbase, cbase;
  if (item < 256) { int b = item >> 7, rem = item & 127; h = rem >> 5; qrow0 = MCTX + b * 4096 + (rem & 31) * 128; nkt = 72; kbase = MCTX + b * 4096; cbase = MT_ROWS + b * 512; }
  else { int it = item - 256, s = it >> 3, rem = it & 7; h = rem >> 1; qrow0 = s * 256 + (rem & 1) * 128; nkt = 4; kbase = s * 256; cbase = 0; }
  bf16x8 Qf[2][3];
#pragma unroll
  for (int qg = 0; qg < 2; ++qg)
#pragma unroll
    for (int ks = 0; ks < 3; ++ks) Qf[qg][ks] = *(const bf16x8*)(qb + (size_t)(qrow0 + wid * 32 + qg * 16 + fr) * 384 + h * 96 + ks * 32 + fq * 8);
  f32x4 O[2][4];
#pragma unroll
  for (int qg = 0; qg < 2; ++qg)
#pragma unroll
    for (int dv = 0; dv < 4; ++dv) O[qg][dv] = (f32x4){0.f, 0.f, 0.f, 0.f};
  float mrun[2] = {-1e30f, -1e30f}, lrun[2] = {0.f, 0.f};
  uint4 gk0, gk1, gk2, gv0, gv1;
  const int kr0 = tid / 12, kc0 = tid % 12, kr1 = (tid + 256) / 12, kc1 = (tid + 256) % 12, kr2 = (tid + 512) / 12, kc2 = (tid + 512) % 12;
  const int vr0 = tid >> 3, vc0 = tid & 7, vr1 = vr0 + 32;
#define A_GLOAD(kt_) do { const int krow0_ = (kt_) < 64 ? kbase + (kt_) * 64 : cbase + ((kt_) - 64) * 64; \
    gk0 = *(const uint4*)(kb + ((size_t)(krow0_ + kr0) * 4 + h) * 96 + kc0 * 8); \
    gk1 = *(const uint4*)(kb + ((size_t)(krow0_ + kr1) * 4 + h) * 96 + kc1 * 8); \
    gk2 = *(const uint4*)(kb + ((size_t)(krow0_ + kr2) * 4 + h) * 96 + kc2 * 8); \
    gv0 = *(const uint4*)(vt + (size_t)(h * 64 + vr0) * MKV + krow0_ + vc0 * 8); \
    gv1 = *(const uint4*)(vt + (size_t)(h * 64 + vr1) * MKV + krow0_ + vc0 * 8); } while (0)
#define A_SSTORE(b_) do { u16* kd_ = lds + (b_) * STG; u16* vd_ = kd_ + 64 * KS; \
    *(uint4*)(kd_ + kr0 * KS + kc0 * 8) = gk0; *(uint4*)(kd_ + kr1 * KS + kc1 * 8) = gk1; *(uint4*)(kd_ + kr2 * KS + kc2 * 8) = gk2; \
    { const int sub_ = vc0 >> 2, G0_ = (vc0 & 3) * 2, G1_ = G0_ + 1; \
      *(uint2*)(vd_ + vr0 * VS + sub_ * 32 + (G0_ & 3) * 8 + (G0_ >> 2) * 4) = make_uint2(gv0.x, gv0.y); \
      *(uint2*)(vd_ + vr0 * VS + sub_ * 32 + (G1_ & 3) * 8 + (G1_ >> 2) * 4) = make_uint2(gv0.z, gv0.w); \
      *(uint2*)(vd_ + vr1 * VS + sub_ * 32 + (G0_ & 3) * 8 + (G0_ >> 2) * 4) = make_uint2(gv1.x, gv1.y); \
      *(uint2*)(vd_ + vr1 * VS + sub_ * 32 + (G1_ & 3) * 8 + (G1_ >> 2) * 4) = make_uint2(gv1.z, gv1.w); } } while (0)
  __syncthreads();
  A_GLOAD(0);
  A_SSTORE(0);
  __syncthreads();
  for (int kt = 0; kt < nkt; ++kt) {
    const int bsel = kt & 1;
    if (kt + 1 < nkt) A_GLOAD(kt + 1);
    const u16* kl = lds + bsel * STG;
    const u16* vl = kl + 64 * KS;
#pragma unroll
    for (int st = 0; st < 2; ++st) {
      bf16x8 Kf[2][3];
#pragma unroll
      for (int sub = 0; sub < 2; ++sub)
#pragma unroll
        for (int ks = 0; ks < 3; ++ks) Kf[sub][ks] = *(const bf16x8*)(kl + (st * 32 + sub * 16 + fr) * KS + ks * 32 + fq * 8);
      bf16x8 Vf[4];
#pragma unroll
      for (int dv = 0; dv < 4; ++dv) Vf[dv] = *(const bf16x8*)(vl + (dv * 16 + fr) * VS + st * 32 + fq * 8);
#pragma unroll
      for (int qg = 0; qg < 2; ++qg) {
        f32x4 sc[2];
#pragma unroll
        for (int sub = 0; sub < 2; ++sub) {
          sc[sub] = (f32x4){0.f, 0.f, 0.f, 0.f};
#pragma unroll
          for (int ks = 0; ks < 3; ++ks) sc[sub] = __builtin_amdgcn_mfma_f32_16x16x32_bf16(Kf[sub][ks], Qf[qg][ks], sc[sub], 0, 0, 0);
        }
        float mx = fmaxf(fmaxf(fmaxf(sc[0][0], sc[0][1]), fmaxf(sc[0][2], sc[0][3])), fmaxf(fmaxf(sc[1][0], sc[1][1]), fmaxf(sc[1][2], sc[1][3])));
        mx = xrow_max(mx);
        const float mn = fmaxf(mrun[qg], mx);
        const float alpha = __builtin_amdgcn_exp2f(mrun[qg] - mn);
        mrun[qg] = mn;
        float pv[8], ps = 0.f;
#pragma unroll
        for (int sub = 0; sub < 2; ++sub)
#pragma unroll
          for (int j = 0; j < 4; ++j) { pv[sub * 4 + j] = __builtin_amdgcn_exp2f(sc[sub][j] - mn); ps += pv[sub * 4 + j]; }
        lrun[qg] = lrun[qg] * alpha + ps;
        uint4 pw = make_uint4(pack2(pv[0], pv[1]), pack2(pv[2], pv[3]), pack2(pv[4], pv[5]), pack2(pv[6], pv[7]));
        bf16x8 pb = __builtin_bit_cast(bf16x8, pw);
        if (__builtin_amdgcn_ballot_w64(alpha < 1.f)) {
#pragma unroll
          for (int dv = 0; dv < 4; ++dv) { O[qg][dv][0] *= alpha; O[qg][dv][1] *= alpha; O[qg][dv][2] *= alpha; O[qg][dv][3] *= alpha; }
        }
#pragma unroll
        for (int dv = 0; dv < 4; ++dv) O[qg][dv] = __builtin_amdgcn_mfma_f32_16x16x32_bf16(Vf[dv], pb, O[qg][dv], 0, 0, 0);
      }
    }
    if (kt + 1 < nkt) A_SSTORE(bsel ^ 1);
    __syncthreads();
  }
#undef A_GLOAD
#undef A_SSTORE
#pragma unroll
  for (int qg = 0; qg < 2; ++qg) {
    const float inv = 1.f / xrow_sum(lrun[qg]);
    const size_t row = (size_t)(qrow0 + wid * 32 + qg * 16 + fr);
#pragma unroll
    for (int dv = 0; dv < 4; ++dv) {
      uint2 w; w.x = pack2(O[qg][dv][0] * inv, O[qg][dv][1] * inv); w.y = pack2(O[qg][dv][2] * inv, O[qg][dv][3] * inv);
      *(uint2*)(mix + row * LDH + 256 + h * 64 + dv * 16 + fq * 4) = w;
    }
  }
}

DEV void post_item(const P& p, int l, int item) {
  GCF proj = (GCF)(p.ws + W_BIG);
  GCF rwa = (GCF)(p.ws + W_RWA); GCF rwo = (GCF)(p.ws + W_RWO);
  GCF rwg = (GCF)(p.ws + W_RWG); GCF hgo = (GCF)(p.ws + W_HGO);
  GU mix = (GU)(p.ws + W_MIX);
  const int j = tid_();
  const float ka = IN(I_RKA)[l * 256 + j], rk = IN(I_RRK)[l * 256 + j], gng = IN(I_RGNG)[l * 256 + j], gnb = IN(I_RGNB)[l * 256 + j];
  const float hgg = IN(I_HGN)[l * 256 + j];
#pragma unroll 1
  for (int tb = 0; tb < 4; ++tb) {
    float r[4], k[4], v[4], a0[4], a1[4], o0[4], o1[4], g[4], h0[4], h1[4], xg[4];
#pragma unroll
    for (int i = 0; i < 4; ++i) {
      const size_t m = (size_t)item * 16 + tb * 4 + i;
      auto pr = proj + m * PLD;
      r[i] = pr[C_AR + j]; k[i] = pr[C_AK + j]; v[i] = pr[C_AV + j]; xg[i] = pr[C_DG + j];
      a0[i] = rwa[m * 256 + j]; a1[i] = rwa[((size_t)MT_ROWS + m) * 256 + j];
      o0[i] = rwo[m * 256 + j]; o1[i] = rwo[((size_t)MT_ROWS + m) * 256 + j];
      g[i] = rwg[m * 256 + j]; h0[i] = hgo[m * 256 + j]; h1[i] = hgo[((size_t)MT_ROWS + m) * 256 + j];
    }
#pragma unroll
    for (int i = 0; i < 4; ++i) {
      const size_t m = (size_t)item * 16 + tb * 4 + i;
      float kd0 = k[i] * (1.f + (a0[i] - 1.f) * ka), kd1 = k[i] * (1.f + (a1[i] - 1.f) * ka);
      float bsum = wave_sum(r[i] * (kd0 + kd1) * rk);
      float of = o0[i] + o1[i];
      float mu = wave_sum(of) * (1.f / 64.f);
      float dv = of - mu;
      float var = wave_sum(dv * dv) * (1.f / 64.f);
      float gn = dv * rsqrtf(var + 64e-5f) * gng + gnb;
      float y = (gn + bsum * v[i]) * g[i];
      mix[m * LDH + j] = f2bf(y);
      float o = h0[i] + h1[i];
      float rs = rsqrtf(wave_sum(o * o) * (1.f / 64.f) + 1e-6f);
      mix[m * LDH + 768 + j] = f2bf(o * rs * hgg * siluf_(xg[i]));
    }
  }
}

constexpr int NPH = 2 + 4 * 12;
__global__ void __launch_bounds__(256, 2) fwd_kernel(P p0, int ph0, int ph1) {
  P p = p0;
  __shared__ __attribute__((aligned(16))) char smem[73728];
  __shared__ uint4 xbw;
  __shared__ int s_item;
  cg::grid_group grid = cg::this_grid();
  if (p.never) grid.sync();
  unsigned* bar = (unsigned*)(p0.ws + W_BAR);
  unsigned* ctr = (unsigned*)(p0.ws + W_CTR);
  const bool multi = (ph1 - ph0) > 1;
  XcdBarrier xb; xb.bar = bar; xb.x = 0; xb.st = (volatile unsigned*)&xbw;
  if (multi) {
    if (tid_() == 0) xbw = make_uint4(0u, 0u, 0u, 0u);
    __syncthreads();
    xb.x = xb_xcc_id();
    if (tid_() == 0) (void)xb_add(&bar[XB_XCNT(xb.x)], 1u);
  }
  for (int ph = ph0; ph < ph1; ++ph) {
    { char* w_ = p0.ws; float* o_ = p0.out; asm volatile("" : "+s"(w_), "+s"(o_)); p.ws = w_; p.out = o_; }
    GCU hbuf = (GCU)(p.ws + W_H);
    GCU actb = (GCU)(p.ws + W_BIG);
    if (ph == 0) phase_setup0(p, smem);
    else if (ph == 1) phase_setup1(p);
    else {
      const int l = (ph - 2) / 12, q = (ph - 2) % 12;
      unsigned* pc = ctr + ph * 64;
      if (q == 0 || q == 9) {
        const int jf = q == 0 ? 0 : 1;
        gemm_phase<EPI_ACT>(p, hbuf, LDH, (GCU)(p.ws + W_WFI) + (size_t)(l * 2 + jf) * 5632 * LDH, LDH, 1024, 96, 44, EpiArg{l, 0, 0.f}, smem);
      } else if (q == 1 || q == 10) {
        const int jf = q == 1 ? 0 : 1;
        gemm_res_phase(p, actb, LDF, (GCU)(p.ws + W_WFO) + (size_t)(l * 2 + jf) * 1024 * LDF, LDF, DFF, EpiArg{l, jf == 0 ? 2 : 8, 0.5f}, smem);
      } else if (q == 2) phase_ln(p, l, 0, l, 3, false);
      else if (q == 8) phase_ln(p, l, 1, l, 6, false);
      else if (q == 11) phase_ln(p, l, 2, l < 3 ? l + 1 : l, 0, l == 3);
      else if (q == 3) {
        gemm_phase<EPI_PROJ>(p, hbuf, LDH, (GCU)(p.ws + W_WIN) + (size_t)l * PLD * LDH, LDH, 1024, 96, 27, EpiArg{l, 0, 0.f}, smem);
      } else if (q == 4) {
        for (;;) {
          int it = next_item(pc, &s_item);
          if (it >= 3472) break;
          if (it < 384) rg_prep_item(p, l, it, smem);
          else if (it < 768) { int t = it - 384; gemm_tile<EPI_LW>(p, (GCU)(p.ws + W_LIN), 384, (GCU)(p.ws + W_LW) + (size_t)l * 512 * 128, 128, 128, (t >> 2) * 128, (t & 3) * 128, EpiArg{l, 0, 0.f}, smem); }
          else if (it < 1152) { int t = it - 768; gemm_tile<EPI_LA>(p, (GCU)(p.ws + W_LIN) + 128, 384, (GCU)(p.ws + W_LA) + (size_t)l * 512 * 128, 128, 128, (t >> 2) * 128, (t & 3) * 128, EpiArg{l, 0, 0.f}, smem); }
          else if (it < 1344) { int t = it - 1152; gemm_tile<EPI_LG>(p, (GCU)(p.ws + W_LIN) + 256, 384, (GCU)(p.ws + W_LG) + (size_t)l * 256 * 128, 128, 128, (t >> 1) * 128, (t & 1) * 128, EpiArg{l, 0, 0.f}, smem); }
          else if (it < 1728) rwkv_prep_item(p, l, it - 1344, smem);
          else if (it < 1936) mla_prep_item(p, l, it - 1728);
          else hgrn_a_item(p, l, it - 1936, smem);
        }
      } else if (q == 5) {
        enum { Q0 = 0, KV0 = Q0 + 96, RW0 = KV0 + 104, HB0 = RW0 + 448, AT0 = HB0 + 384, RG0 = AT0 + 256, RC0 = RG0 + 384, FX0 = RC0 + 512,
               AC0 = FX0 + 384, HC0 = AC0 + 128, END0 = HC0 + 1536, NGEMM = 200 };
        for (;;) {
          int it = next_item(pc, &s_item);
          if (it >= END0) break;
          if (it < KV0) {
#pragma unroll 1
            for (int nt = 0; nt < 3; ++nt) gemm_tile<EPI_Q>(p, (GCU)(p.ws + W_CQN), 256, (GCU)(p.ws + W_WUQ) + (size_t)l * 384 * 256, 256, 256, it * 128, nt * 128, EpiArg{l, 0, 0.f}, smem);
            item_publish(pc + 16);
          } else if (it < RW0) {
            const int t = it - KV0;
#pragma unroll 1
            for (int nt = 0; nt < 4; ++nt) gemm_tile<EPI_KV>(p, (GCU)(p.ws + W_CKVN), 128, (GCU)(p.ws + W_WUKV) + (size_t)l * 512 * 128, 128, 128, t * 128, nt * 128, EpiArg{l, 0, 0.f}, smem);
            item_publish(pc + 16);
          } else if (it < HB0) {
            int t = it - RW0, combo = t / 28, r = t % 28;
            int c = r < 4 ? 0 : 1 + (r - 4) / 8, g = r < 4 ? r : (r - 4) & 7;
            rwkv_scan_item(p, l, 16 + (combo >> 3), (combo >> 2) & 1, combo & 3, c, 4, g, smem);
            item_publish(pc + 40 + combo);
          }
          else if (it < AT0) { hgrn_b_item(p, l, it - HB0); item_publish(pc + 32); }
          else if (it < RG0) { item_wait(pc + 16, NGEMM); attn_item(p, it - AT0, smem); }
          else if (it < RC0) rg_scan_item(p, l, it - RG0, smem);
          else if (it < FX0) { int t = it - RC0; rwkv_scan_item(p, l, t >> 5, (t >> 4) & 1, (t >> 2) & 3, 0, 1, t & 3, smem); }
          else if (it < AC0) { int t = it - FX0; item_wait(pc + 40 + t / 24, 28u); rwkv_fix_item(p, l, t, smem); }
          else if (it < HC0) { item_wait(pc + 16, NGEMM); attn_item(p, it - AC0 + 256, smem); }
          else { item_wait(pc + 32, 384u); hgrn_c_item(p, l, it - HC0, smem); }
        }
      } else if (q == 6) {
        for (;;) {
          int it = next_item(pc, &s_item);
          if (it >= 768) break;
          post_item(p, l, it);
        }
      } else if (q == 7) {
        gemm_res_phase(p, (GCU)(p.ws + W_MIX), LDH, (GCU)(p.ws + W_WOUT) + (size_t)l * 1024 * LDH, LDH, 1024, EpiArg{l, 5, 1.0f}, smem);
      }
    }
    if (multi && ph + 1 < ph1) xcd_barrier(xb);
  }
}

#ifndef SINGLE_LAUNCH
#define SINGLE_LAUNCH 1
#endif

extern "C" void kernel_launch(void* const* d_in, const int* in_sizes, int n_in, void* d_out, int out_size, void* d_ws, size_t ws_size,
                              hipStream_t stream) {
  if (ws_size < W_END || n_in < 40) { fprintf(stderr, "workspace too small: %zu < %zu\n", ws_size, (size_t)W_END); return; }
  static int grid_blocks = 0;
  if (!grid_blocks) {
    int dev = 0, cus = 0, per_cu = 0;
    hipGetDevice(&dev);
    hipDeviceGetAttribute(&cus, hipDeviceAttributeMultiprocessorCount, dev);
    hipOccupancyMaxActiveBlocksPerMultiprocessor(&per_cu, fwd_kernel, 256, 0);
    if (per_cu > 2) per_cu = 2;
    if (per_cu < 1) per_cu = 1;
    grid_blocks = cus * per_cu;
  }
  P p{};
  for (int i = 0; i < 40; ++i) p.in[i] = (const float*)d_in[i];
  p.out = (float*)d_out; p.ws = (char*)d_ws; p.never = 0; p.pad = 0;
  hipMemsetAsync(d_ws, 0, 32768, stream);
#if SINGLE_LAUNCH
  int ph0 = 0, ph1 = NPH;
  void* args[] = {&p, &ph0, &ph1};
  hipError_t e = hipLaunchCooperativeKernel((void*)fwd_kernel, dim3(grid_blocks), dim3(256), args, 0, stream);
  if (e != hipSuccess) fprintf(stderr, "cooperative launch failed: %s (grid %d)\n", hipGetErrorString(e), grid_blocks);
#else
  for (int ph = 0; ph < NPH; ++ph) fwd_kernel<<<grid_blocks, 256, 0, stream>>>(p, ph, ph + 1);
#endif
}
```
